# Optimizing an MI355X kernel written in HIP

```python
import math
import jax, jax.numpy as jnp
from jax import lax
import numpy as np

D_MODEL = 2048
BATCH = 2
SEQ = 4096
DEPTH = 1

HEAD_DIM = 64
N_Q_HEADS = D_MODEL // 128
N_KV_HEADS = 4
Q_PER_KV = N_Q_HEADS // N_KV_HEADS
ATTN_W = N_Q_HEADS * HEAD_DIM
KV_W = N_KV_HEADS * HEAD_DIM
WINDOW = 128
BLOCK = 128
SSM_W = D_MODEL // 2
GROUP = 16
N_GROUPS = SSM_W // GROUP
STATE = 64
IN_SIZES = (ATTN_W, KV_W, KV_W, ATTN_W, SSM_W, SSM_W, D_MODEL, D_MODEL)
IN_W = sum(IN_SIZES)
NORM_EPS = 1e-6

kernel_name = "hybrid_swa_sink_s5_gated_merge"


def rms_norm(x, w):
    xf = x.astype(jnp.float32)
    y = xf * lax.rsqrt(jnp.mean(xf * xf, axis=-1, keepdims=True) + NORM_EPS)
    return (y * w.astype(jnp.float32)).astype(x.dtype)


def sliding_window_attention(q, k, v, sinks):
    b, l = q.shape[0], q.shape[1]
    nb = l // BLOCK
    qb = q.reshape(b, nb, BLOCK, N_KV_HEADS, Q_PER_KV, HEAD_DIM)
    kb = k.reshape(b, nb, BLOCK, N_KV_HEADS, HEAD_DIM)
    vb = v.reshape(b, nb, BLOCK, N_KV_HEADS, HEAD_DIM)
    k_prev = jnp.concatenate([jnp.zeros_like(kb[:, :1]), kb[:, :-1]], axis=1)
    v_prev = jnp.concatenate([jnp.zeros_like(vb[:, :1]), vb[:, :-1]], axis=1)
    kk = jnp.concatenate([k_prev, kb], axis=2)
    vv = jnp.concatenate([v_prev, vb], axis=2)
    scale = 1.0 / math.sqrt(HEAD_DIM)
    scores = jnp.einsum('bnqgrd,bnsgd->bngrqs', qb, kk).astype(jnp.float32) * scale
    q_loc = jnp.arange(BLOCK)[:, None] + BLOCK
    k_loc = jnp.arange(2 * BLOCK)[None, :]
    diff = q_loc - k_loc
    k_abs = (jnp.arange(nb)[:, None, None] - 1) * BLOCK + k_loc[None]
    valid = (diff >= 0)[None] & (diff < WINDOW)[None] & (k_abs >= 0)
    scores = jnp.where(valid[None, :, None, None], scores, -1e30)
    sink = jnp.broadcast_to(
        sinks.astype(jnp.float32).reshape(1, 1, N_KV_HEADS, Q_PER_KV, 1, 1),
        scores.shape[:-1] + (1,))
    probs = jax.nn.softmax(jnp.concatenate([scores, sink], axis=-1), axis=-1)[..., :-1]
    out = jnp.einsum('bngrqs,bnsgd->bnqgrd', probs.astype(v.dtype), vv)
    return out.reshape(b, l, ATTN_W)


def s5_ssm(u, A_re, A_im, log_dt, B_re, B_im, C_re, C_im, D_skip):
    dt = jnp.exp(log_dt)[:, None]
    mag = jnp.exp(dt * A_re)
    ab_re = mag * jnp.cos(dt * A_im)
    ab_im = mag * jnp.sin(dt * A_im)
    num_re = ab_re - 1.0
    num_im = ab_im
    den = A_re * A_re + A_im * A_im
    cf_re = (num_re * A_re + num_im * A_im) / den
    cf_im = (num_im * A_re - num_re * A_im) / den
    bu_re = jnp.einsum('blgh,gph->blgp', u, B_re)
    bu_im = jnp.einsum('blgh,gph->blgp', u, B_im)
    b_re = cf_re * bu_re - cf_im * bu_im
    b_im = cf_re * bu_im + cf_im * bu_re
    a_re = jnp.broadcast_to(ab_re, b_re.shape)
    a_im = jnp.broadcast_to(ab_im, b_im.shape)

    def combine(e1, e2):
        a1r, a1i, b1r, b1i = e1
        a2r, a2i, b2r, b2i = e2
        return (a2r * a1r - a2i * a1i,
                a2r * a1i + a2i * a1r,
                a2r * b1r - a2i * b1i + b2r,
                a2r * b1i + a2i * b1r + b2i)

    _, _, s_re, s_im = lax.associative_scan(combine, (a_re, a_im, b_re, b_im), axis=1)
    y = (jnp.einsum('blgp,ghp->blgh', s_re, C_re)
         - jnp.einsum('blgp,ghp->blgh', s_im, C_im)
         + D_skip * u)
    return y


def setup_inputs(seed: int = 0) -> dict:
    key = jax.random.key(seed)
    ks = jax.random.split(key, 20)
    f32 = jnp.float32
    n = jnp.arange(STATE, dtype=f32)
    x = jax.random.normal(ks[0], (BATCH, SEQ, D_MODEL), f32)
    norm_w = 1.0 + 0.02 * jax.random.normal(ks[1], (D_MODEL,), f32)
    w_in = jax.random.normal(ks[2], (D_MODEL, IN_W), f32) * D_MODEL ** -0.5
    q_norm_w = 1.0 + 0.02 * jax.random.normal(ks[3], (HEAD_DIM,), f32)
    k_norm_w = 1.0 + 0.02 * jax.random.normal(ks[4], (HEAD_DIM,), f32)
    sinks = jax.random.normal(ks[5], (N_Q_HEADS,), f32)
    w_attn_proj = jax.random.normal(ks[6], (ATTN_W, D_MODEL), f32) * ATTN_W ** -0.5
    A_re = -0.5 + 0.01 * jax.random.normal(ks[7], (N_GROUPS, STATE), f32)
    A_im = math.pi * n[None, :] + 0.01 * jax.random.normal(ks[8], (N_GROUPS, STATE), f32)
    log_dt = jax.random.uniform(ks[9], (N_GROUPS,), f32, math.log(1e-3), math.log(1e-1))
    b_scale = (2.0 * GROUP) ** -0.5
    B_re = jax.random.normal(ks[10], (N_GROUPS, STATE, GROUP), f32) * b_scale
    B_im = jax.random.normal(ks[11], (N_GROUPS, STATE, GROUP), f32) * b_scale
    c_scale = (2.0 * STATE) ** -0.5
    C_re = jax.random.normal(ks[12], (N_GROUPS, GROUP, STATE), f32) * c_scale
    C_im = jax.random.normal(ks[13], (N_GROUPS, GROUP, STATE), f32) * c_scale
    D_skip = jax.random.normal(ks[14], (N_GROUPS, GROUP), f32)
    w_glu = jax.random.normal(ks[15], (SSM_W, 2 * SSM_W), f32) * SSM_W ** -0.5
    b_glu = 0.01 * jax.random.normal(ks[16], (2 * SSM_W,), f32)
    w_ssm_proj = jax.random.normal(ks[17], (SSM_W, D_MODEL), f32) * SSM_W ** -0.5
    w_out = jax.random.normal(ks[18], (D_MODEL, D_MODEL), f32) * D_MODEL ** -0.5
    return {"x": x, "norm_w": norm_w, "w_in": w_in, "q_norm_w": q_norm_w,
            "k_norm_w": k_norm_w, "sinks": sinks, "w_attn_proj": w_attn_proj,
            "A_re": A_re, "A_im": A_im, "log_dt": log_dt, "B_re": B_re, "B_im": B_im,
            "C_re": C_re, "C_im": C_im, "D_skip": D_skip, "w_glu": w_glu,
            "b_glu": b_glu, "w_ssm_proj": w_ssm_proj, "w_out": w_out}


def reference(x, norm_w, w_in, q_norm_w, k_norm_w, sinks, w_attn_proj, A_re, A_im,
              log_dt, B_re, B_im, C_re, C_im, D_skip, w_glu, b_glu, w_ssm_proj, w_out):
    b, l, _ = x.shape
    split_pts = list(np.cumsum(IN_SIZES)[:-1])
    f32 = jnp.float32
    for _layer in range(DEPTH):
        h = rms_norm(x, norm_w)
        proj = h @ w_in
        q, k, v, a_gate, u, z, g_a, g_s = jnp.split(proj, split_pts, axis=-1)
        q = rms_norm(q.reshape(b, l, N_Q_HEADS, HEAD_DIM), q_norm_w)
        k = rms_norm(k.reshape(b, l, N_KV_HEADS, HEAD_DIM), k_norm_w)
        v = v.reshape(b, l, N_KV_HEADS, HEAD_DIM)
        attn = sliding_window_attention(q, k, v, sinks)
        y_a = (attn * jax.nn.silu(a_gate)) @ w_attn_proj
        u_g = u.reshape(b, l, N_GROUPS, GROUP).astype(f32)
        y_ssm = s5_ssm(u_g, A_re.astype(f32), A_im.astype(f32), log_dt.astype(f32),
                       B_re.astype(f32), B_im.astype(f32), C_re.astype(f32),
                       C_im.astype(f32), D_skip.astype(f32))
        y_ssm = jax.nn.gelu(y_ssm.reshape(b, l, SSM_W)).astype(x.dtype)
        glu_a, glu_b = jnp.split(y_ssm @ w_glu + b_glu, 2, axis=-1)
        y_s = (glu_a * jax.nn.sigmoid(glu_b) * jax.nn.silu(z)) @ w_ssm_proj
        merged = jax.nn.sigmoid(g_a) * y_a + jax.nn.sigmoid(g_s) * y_s
        x = x + merged @ w_out
    return x
```

```cpp
#include <hip/hip_runtime.h>
#include <hip/hip_cooperative_groups.h>
#include <cstdio>
#include <cstdint>
namespace cg = cooperative_groups;
namespace pg8 {
#define PG8_LAS __attribute__((address_space(3)))
typedef unsigned short bf16_t;
typedef short bf16x8 __attribute__((ext_vector_type(8)));
typedef float f32x4 __attribute__((ext_vector_type(4)));
typedef unsigned u32x4 __attribute__((ext_vector_type(4)));
constexpr int BM = 256, BK = 64, HALF = 128, HTB = HALF * BK * 2  , STAGE_BYTES = 8 * HTB, NXCD = 8, WGM = 8;

__host__ __device__ __forceinline__ int lds_byte(int r, int c) { const int st = (r >> 4) * 2 + (c >> 5), rr = r & 15, cc = c & 31, ob = rr * 64 + cc * 2; return st * 1024 + (ob ^ (((ob >> 9) & 1) << 5)); }
__host__ __device__ __forceinline__ void stage_rc(int b, int& R, int& C) { const int st = b / 1024, sb = b % 1024, swz = sb ^ (((sb >> 9) & 1) << 5); R = (st >> 1) * 16 + swz / 64; C = (st & 1) * 32 + (swz % 64) / 2; }
__host__ __device__ __forceinline__ int perm32(int rho) { const int n = rho >> 4, i = rho & 15; return 8 * (i >> 2) + 4 * n + (i & 3); }

struct Unit { int pm, pn; };
struct Gemm { const bf16_t* A; const bf16_t* Bt; int M, N, K; };

struct StaticOrder {
    int nM, nN, nwg, G, c;
    __host__ __device__ void init(int M, int N, int G_, int c_) { nM = M / BM; nN = N / BM; nwg = nM * nN; G = G_; c = c_; }
    __host__ __device__ bool next(int i, Unit& u) const {
        const long L = (long)i * G + c; if (L >= nwg) return false;
        int wgid = (int)L; { const int q = nwg / NXCD, r = nwg % NXCD, xcd = wgid % NXCD, off = wgid / NXCD; wgid = (xcd < r ? xcd * (q + 1) : r * (q + 1) + (xcd - r) * q) + off; }
        const int nig = WGM * nN, gid = wgid / nig, fm = gid * WGM, gsz = (nM - fm) < WGM ? (nM - fm) : WGM;
        u.pm = fm + ((wgid % nig) % gsz); u.pn = (wgid % nig) / gsz; return true;
    }
    __device__ __forceinline__ void a_ready(const Unit&) const {}
    __device__ __forceinline__ void done(const Unit&) const {}
};

__device__ __forceinline__ unsigned cvt_pk_bf16(float lo, float hi) { unsigned r; asm volatile("v_cvt_pk_bf16_f32 %0, %1, %2" : "=v"(r) : "v"(lo), "v"(hi)); return r; }
template <class Epi, class Sched, bool ALIGN_EPI = false, bool SP2 = false>
__device__ __forceinline__ void gemm_phase(PG8_LAS unsigned char* lds, const Gemm g, const Sched& S, const Epi& E) {
    const int tid = threadIdx.x, wid = __builtin_amdgcn_readfirstlane(tid >> 6), lane = tid & 63, wr = wid >> 2, wc = wid & 3, fr = lane & 15, fq = lane >> 4;
    const int K = g.K, nt = K / BK;
    unsigned voffA[2], voffB[2];
#pragma unroll
    for (int i = 0; i < 2; ++i) { int R, C; stage_rc(tid * 16 + i * 8192, R, C); const int Rb = Epi::PERM ? ((R & ~31) + perm32(R & 31)) : R;
        voffA[i] = (unsigned)(R * K + C) * 2u; voffB[i] = (unsigned)(Rb * K + C) * 2u; }
    const size_t kstep = (size_t)(BK * 2);
    const size_t hstep = (size_t)HALF * K * 2;
    const size_t tstep = 2 * hstep;
    const unsigned ldsw = (unsigned)wid * 1024u;
    const int aoff = lds_byte(wr * 64 + fr, fq * 8), boff = lds_byte(wc * 32 + fr, fq * 8);
#define PG8_SA(b, h) (((b) * 2 + (h)) * HTB)
#define PG8_SB(b, h) ((4 + (b) * 2 + (h)) * HTB)
#define PG8_STAGE(bufoff, gbase, voff) do { _Pragma("unroll") for (int _i = 0; _i < 2; ++_i) \
        __builtin_amdgcn_global_load_lds((const unsigned*)((const char*)(gbase) + (voff)[_i]), (PG8_LAS unsigned*)(lds + (bufoff) + ldsw + _i * 8192), 16, 0, 0); } while (0)
#define PG8_LDA(dst, b, h) do { _Pragma("unroll") for (int m = 0; m < 4; ++m) _Pragma("unroll") for (int k = 0; k < 2; ++k) dst[m][k] = *(const PG8_LAS bf16x8*)(lds + PG8_SA(b, h) + aoff + m * 2048 + k * 1024); } while (0)
#define PG8_LDB(dst, b, h) do { _Pragma("unroll") for (int n = 0; n < 2; ++n) _Pragma("unroll") for (int k = 0; k < 2; ++k) dst[n][k] = *(const PG8_LAS bf16x8*)(lds + PG8_SB(b, h) + boff + n * 2048 + k * 1024); } while (0)
#define PG8_MMA(ai, bj, At, Bt) do { __builtin_amdgcn_s_setprio(1); _Pragma("unroll") for (int m = 0; m < 4; ++m) _Pragma("unroll") for (int n = 0; n < 2; ++n) _Pragma("unroll") for (int k = 0; k < 2; ++k) \
        acc[ai][bj][m][n] = __builtin_amdgcn_mfma_f32_16x16x32_bf16(Bt[n][k], At[m][k], acc[ai][bj][m][n], 0, 0, 0); __builtin_amdgcn_s_setprio(0); } while (0)
#define PG8_WAIT_V(n) asm volatile("s_waitcnt vmcnt(" #n ")" ::: "memory")
#define PG8_WAIT_L(n) asm volatile("s_waitcnt lgkmcnt(" #n ")" ::: "memory")
#define PG8_BAR __builtin_amdgcn_s_barrier()
#define PG8_SCHED __builtin_amdgcn_sched_barrier(0)
    Unit cur, nxt; int ui = 0;
    if (!S.next(0, cur)) return;
    f32x4 acc[2][2][4][2];
#pragma unroll
    for (int a = 0; a < 2; ++a)
#pragma unroll
        for (int b = 0; b < 2; ++b)
#pragma unroll
            for (int m = 0; m < 4; ++m)
#pragma unroll
                for (int n = 0; n < 2; ++n) acc[a][b][m][n] = (f32x4){0.f, 0.f, 0.f, 0.f};
    bf16x8 At[4][2], B0[2][2], B1[2][2];
    const char* cA = (const char*)g.A + (size_t)cur.pm * tstep; const char* cB = (const char*)g.Bt + (size_t)cur.pn * tstep;
    S.a_ready(cur);
    if constexpr (SP2) {
        PG8_STAGE(PG8_SB(0, 0), cB, voffB); PG8_STAGE(PG8_SB(0, 1), cB + hstep, voffB); PG8_STAGE(PG8_SA(0, 0), cA, voffA); PG8_STAGE(PG8_SA(0, 1), cA + hstep, voffA);
        if (wr == 1) PG8_BAR;
        PG8_WAIT_V(2); PG8_BAR;
        PG8_STAGE(PG8_SB(1, 0), cB + kstep, voffB); PG8_STAGE(PG8_SA(1, 0), cA + kstep, voffA); PG8_STAGE(PG8_SB(1, 1), cB + hstep + kstep, voffB);
        PG8_WAIT_V(6); PG8_BAR;
    } else {
        PG8_STAGE(PG8_SB(0, 0), cB, voffB); PG8_STAGE(PG8_SA(0, 0), cA, voffA); PG8_STAGE(PG8_SB(0, 1), cB + hstep, voffB); PG8_STAGE(PG8_SA(0, 1), cA + hstep, voffA);
        if (wr == 1) PG8_BAR;
        PG8_WAIT_V(4); PG8_BAR;
        PG8_STAGE(PG8_SB(1, 0), cB + kstep, voffB); PG8_STAGE(PG8_SA(1, 0), cA + kstep, voffA); PG8_STAGE(PG8_SB(1, 1), cB + hstep + kstep, voffB);
        PG8_WAIT_V(6); PG8_BAR;
    }
    for (;;) {
        const bool has_next = S.next(ui + 1, nxt);
        const char* nA = has_next ? (const char*)g.A + (size_t)nxt.pm * tstep : cA; const char* nB = has_next ? (const char*)g.Bt + (size_t)nxt.pn * tstep : cB;
        for (int t = 0; t < nt; t += 2) {
            const bool last = (t == nt - 2);
            const char* a1 = cA + (size_t)(t + 1) * kstep;
            const char* a2 = last ? nA : cA + (size_t)(t + 2) * kstep; const char* b2 = last ? nB : cB + (size_t)(t + 2) * kstep;
            const char* a3 = a2 + kstep; const char* b3 = b2 + kstep;
            if (last && has_next) S.a_ready(nxt);
            if constexpr (SP2) {
            PG8_LDB(B0, 0, 0); PG8_LDB(B1, 0, 1); PG8_SCHED; PG8_LDA(At, 0, 0); PG8_STAGE(PG8_SA(1, 1), a1 + hstep, voffA);
            PG8_WAIT_V(8); PG8_WAIT_L(0); PG8_BAR; PG8_MMA(0, 0, At, B0); PG8_MMA(0, 1, At, B1); PG8_BAR; PG8_SCHED;
            PG8_LDA(At, 0, 1); PG8_STAGE(PG8_SB(0, 0), b2, voffB); PG8_STAGE(PG8_SB(0, 1), b2 + hstep, voffB); PG8_STAGE(PG8_SA(0, 0), a2, voffA);
            PG8_WAIT_V(8); PG8_WAIT_L(0); PG8_BAR; PG8_MMA(1, 0, At, B0); PG8_MMA(1, 1, At, B1); PG8_BAR; PG8_SCHED;
            PG8_LDB(B0, 1, 0); PG8_LDB(B1, 1, 1); PG8_SCHED; PG8_LDA(At, 1, 0); PG8_STAGE(PG8_SA(0, 1), a2 + hstep, voffA);
            PG8_WAIT_V(8); PG8_WAIT_L(0); PG8_BAR; PG8_MMA(0, 0, At, B0); PG8_MMA(0, 1, At, B1); PG8_BAR; PG8_SCHED;
            PG8_LDA(At, 1, 1); PG8_STAGE(PG8_SB(1, 0), b3, voffB); PG8_STAGE(PG8_SB(1, 1), b3 + hstep, voffB); PG8_STAGE(PG8_SA(1, 0), a3, voffA);
            PG8_WAIT_V(8); PG8_WAIT_L(0); PG8_BAR; PG8_MMA(1, 0, At, B0); PG8_MMA(1, 1, At, B1); PG8_BAR; PG8_SCHED;
            } else {
            PG8_LDB(B0, 0, 0); PG8_SCHED; PG8_LDA(At, 0, 0); PG8_STAGE(PG8_SA(1, 1), a1 + hstep, voffA);
            PG8_WAIT_L(8); PG8_BAR; PG8_WAIT_L(0); PG8_MMA(0, 0, At, B0); PG8_BAR; PG8_SCHED;
            PG8_LDB(B1, 0, 1); PG8_STAGE(PG8_SB(0, 0), b2, voffB);
            PG8_BAR; PG8_WAIT_L(0); PG8_MMA(0, 1, At, B1); PG8_BAR;
            PG8_LDA(At, 0, 1); PG8_STAGE(PG8_SA(0, 0), a2, voffA);
            PG8_BAR; PG8_WAIT_L(0); PG8_MMA(1, 0, At, B0); PG8_BAR; PG8_SCHED;
            PG8_STAGE(PG8_SB(0, 1), b2 + hstep, voffB);
            PG8_WAIT_V(6); PG8_BAR; PG8_MMA(1, 1, At, B1); PG8_BAR;
            PG8_LDB(B0, 1, 0); PG8_SCHED; PG8_LDA(At, 1, 0); PG8_STAGE(PG8_SA(0, 1), a2 + hstep, voffA);
            PG8_WAIT_L(8); PG8_BAR; PG8_WAIT_L(0); PG8_MMA(0, 0, At, B0); PG8_BAR; PG8_SCHED;
            PG8_LDB(B1, 1, 1); PG8_STAGE(PG8_SB(1, 0), b3, voffB);
            PG8_BAR; PG8_WAIT_L(0); PG8_MMA(0, 1, At, B1); PG8_BAR;
            PG8_LDA(At, 1, 1); PG8_STAGE(PG8_SA(1, 0), a3, voffA);
            PG8_BAR; PG8_WAIT_L(0); PG8_MMA(1, 0, At, B0); PG8_BAR; PG8_SCHED;
            PG8_STAGE(PG8_SB(1, 1), b3 + hstep, voffB);
            PG8_WAIT_V(6); PG8_BAR; PG8_MMA(1, 1, At, B1); PG8_BAR;
            }
        }
        if constexpr (ALIGN_EPI) { if (wr == 0) PG8_BAR; }
        if constexpr (!Epi::AFTER_DRAIN) { E(acc, cur, wr, wc, fr, fq); S.done(cur); }
        if (!has_next) break;
#pragma unroll
        for (int a = 0; a < 2; ++a)
#pragma unroll
            for (int b = 0; b < 2; ++b)
#pragma unroll
                for (int m = 0; m < 4; ++m)
#pragma unroll
                    for (int n = 0; n < 2; ++n) acc[a][b][m][n] = (f32x4){0.f, 0.f, 0.f, 0.f};
        cur = nxt; cA = nA; cB = nB; ++ui;
        if constexpr (ALIGN_EPI) { if (wr == 1) PG8_BAR; }
    }
    PG8_WAIT_V(0);
    if constexpr (!ALIGN_EPI) { if (wr == 0) PG8_BAR; }
    PG8_BAR;
    if constexpr (Epi::AFTER_DRAIN) { E.fused(acc, cur, wr, wc, fr, fq, lds, wid, lane); S.done(cur); }
#undef PG8_SA
#undef PG8_SB
#undef PG8_STAGE
#undef PG8_LDA
#undef PG8_LDB
#undef PG8_MMA
#undef PG8_WAIT_V
#undef PG8_WAIT_L
#undef PG8_BAR
#undef PG8_SCHED
}
}

#ifndef MK_N_LAUNCHES
#define MK_N_LAUNCHES 1
#endif
constexpr int DM = 2048, SEQ = 4096, MTOK = 8192, INW = 8704;
constexpr int C_Q = 0, C_K = 1024, C_V = 1280, C_AG = 1536, C_U = 2560, C_Z = 3584, C_GA = 4608, C_GS = 6656;
constexpr float LOG2E = 1.4426950408889634f;
constexpr size_t MiB = 1u << 20;
constexpr size_t WS_WIN = 0, WS_WATTN = 34 * MiB, WS_WGLU = 38 * MiB, WS_WSSM = 42 * MiB, WS_WOUT = 46 * MiB;
constexpr size_t WS_H = 54 * MiB, WS_ATTNG = 54 * MiB, WS_YG = 70 * MiB, WS_P = 86 * MiB, WS_MG = 0, WS_END = 222 * MiB;
constexpr size_t OUT_T = 0, OUT_E = 16 * MiB;
constexpr int LDS_BYTES = 147456;

#define LAS __attribute__((address_space(3)))
typedef unsigned short bf16_t;
typedef unsigned u32x4 __attribute__((ext_vector_type(4)));
typedef unsigned u32x2 __attribute__((ext_vector_type(2)));
typedef float f32x4 __attribute__((ext_vector_type(4)));
typedef short bf16x8 __attribute__((ext_vector_type(8)));

__device__ __forceinline__ unsigned f2bf(float f) { unsigned u = __builtin_bit_cast(unsigned, f); return (u + 0x7fffu + ((u >> 16) & 1u)) >> 16; }
__device__ __forceinline__ float bf2f(unsigned b) { return __builtin_bit_cast(float, b << 16); }
__device__ __forceinline__ float bflo(unsigned w) { return __builtin_bit_cast(float, w << 16); }
__device__ __forceinline__ float bfhi(unsigned w) { return __builtin_bit_cast(float, w & 0xffff0000u); }
__device__ __forceinline__ unsigned pk2(float lo, float hi) { return pg8::cvt_pk_bf16(lo, hi); }
__device__ __forceinline__ float fsigmoid(float x) { return __builtin_amdgcn_rcpf(1.f + __expf(-x)); }
__device__ __forceinline__ float fsilu(float x) { return x * fsigmoid(x); }
__device__ __forceinline__ float fgelu_tanh(float x) { const float z = 0.7978845608028654f * (x + 0.044715f * x * x * x); return x * fsigmoid(2.f * z); }

namespace pg8 {
struct EpiProj {
    static constexpr bool PERM = true, AFTER_DRAIN = false;
    bf16_t* O;
    __device__ __forceinline__ void operator()(const f32x4 (&acc)[2][2][4][2], const Unit& u, int wr, int wc, int fr, int fq) const {
        const int pn = u.pn;
        const int act = (pn >= 18) ? 2 : (((pn >= 6 && pn < 10) || (pn >= 14 && pn < 18)) ? 1 : 0);
        const int row0 = u.pm * BM + wr * 64 + fr, col0 = pn * BM + wc * 32 + 8 * fq;
#pragma unroll
        for (int ai = 0; ai < 2; ++ai)
#pragma unroll
            for (int m = 0; m < 4; ++m) { bf16_t* rowp = O + (size_t)(row0 + ai * HALF + m * 16) * INW + col0;
#pragma unroll
                for (int bj = 0; bj < 2; ++bj) { f32x4 v0 = acc[ai][bj][m][0], v1 = acc[ai][bj][m][1];
                    if (act == 1) {
#pragma unroll
                        for (int i = 0; i < 4; ++i) { v0[i] = fsilu(v0[i]); v1[i] = fsilu(v1[i]); } }
                    else if (act == 2) {
#pragma unroll
                        for (int i = 0; i < 4; ++i) { v0[i] = fsigmoid(v0[i]); v1[i] = fsigmoid(v1[i]); } }
                    u32x4 w; w.x = cvt_pk_bf16(v0[0], v0[1]); w.y = cvt_pk_bf16(v0[2], v0[3]); w.z = cvt_pk_bf16(v1[0], v1[1]); w.w = cvt_pk_bf16(v1[2], v1[3]);
                    *(u32x4*)(rowp + bj * HALF) = w; } }
    }
};
struct EpiYa {
    static constexpr bool PERM = true, AFTER_DRAIN = false;
    const bf16_t* P; bf16_t* Mg;
    __device__ __forceinline__ void operator()(const f32x4 (&acc)[2][2][4][2], const Unit& u, int wr, int wc, int fr, int fq) const {
        const int row0 = u.pm * BM + wr * 64 + fr, col0 = u.pn * BM + wc * 32 + 8 * fq;
#pragma unroll
        for (int ai = 0; ai < 2; ++ai)
#pragma unroll
            for (int m = 0; m < 4; ++m) { const size_t r = (size_t)(row0 + ai * HALF + m * 16);
#pragma unroll
                for (int bj = 0; bj < 2; ++bj) { const f32x4 v0 = acc[ai][bj][m][0], v1 = acc[ai][bj][m][1];
                    const u32x4 g = *(const u32x4*)(P + r * INW + C_GA + col0 + bj * HALF);
                    u32x4 w; w.x = cvt_pk_bf16(v0[0] * bflo(g.x), v0[1] * bfhi(g.x)); w.y = cvt_pk_bf16(v0[2] * bflo(g.y), v0[3] * bfhi(g.y));
                    w.z = cvt_pk_bf16(v1[0] * bflo(g.z), v1[1] * bfhi(g.z)); w.w = cvt_pk_bf16(v1[2] * bflo(g.w), v1[3] * bfhi(g.w));
                    *(u32x4*)(Mg + r * DM + col0 + bj * HALF) = w; } }
    }
};
struct EpiGlu {
    static constexpr bool PERM = true, AFTER_DRAIN = false;
    const bf16_t* P; bf16_t* T; const float* bias;
    __device__ __forceinline__ void operator()(const f32x4 (&acc)[2][2][4][2], const Unit& u, int wr, int wc, int fr, int fq) const {
        const int row0 = u.pm * BM + wr * 64 + fr, col0 = u.pn * HALF + wc * 32 + 8 * fq;
        const f32x4 ba0 = *(const f32x4*)(bias + col0), ba1 = *(const f32x4*)(bias + col0 + 4);
        const f32x4 bb0 = *(const f32x4*)(bias + 1024 + col0), bb1 = *(const f32x4*)(bias + 1024 + col0 + 4);
#pragma unroll
        for (int ai = 0; ai < 2; ++ai)
#pragma unroll
            for (int m = 0; m < 4; ++m) { const size_t r = (size_t)(row0 + ai * HALF + m * 16);
                const f32x4 a0 = acc[ai][0][m][0] + ba0, a1 = acc[ai][0][m][1] + ba1, b0 = acc[ai][1][m][0] + bb0, b1 = acc[ai][1][m][1] + bb1;
                const u32x4 z = *(const u32x4*)(P + r * INW + C_Z + col0);
                u32x4 w;
                w.x = cvt_pk_bf16(a0[0] * fsigmoid(b0[0]) * bflo(z.x), a0[1] * fsigmoid(b0[1]) * bfhi(z.x));
                w.y = cvt_pk_bf16(a0[2] * fsigmoid(b0[2]) * bflo(z.y), a0[3] * fsigmoid(b0[3]) * bfhi(z.y));
                w.z = cvt_pk_bf16(a1[0] * fsigmoid(b1[0]) * bflo(z.z), a1[1] * fsigmoid(b1[1]) * bfhi(z.z));
                w.w = cvt_pk_bf16(a1[2] * fsigmoid(b1[2]) * bflo(z.w), a1[3] * fsigmoid(b1[3]) * bfhi(z.w));
                *(u32x4*)(T + r * 1024 + col0) = w; }
    }
};
struct EpiYs {
    static constexpr bool PERM = true, AFTER_DRAIN = false;
    const bf16_t* P; bf16_t* Mg;
    __device__ __forceinline__ void operator()(const f32x4 (&acc)[2][2][4][2], const Unit& u, int wr, int wc, int fr, int fq) const {
        const int row0 = u.pm * BM + wr * 64 + fr, col0 = u.pn * BM + wc * 32 + 8 * fq;
#pragma unroll
        for (int ai = 0; ai < 2; ++ai)
#pragma unroll
            for (int m = 0; m < 4; ++m) { const size_t r = (size_t)(row0 + ai * HALF + m * 16);
#pragma unroll
                for (int bj = 0; bj < 2; ++bj) { const f32x4 v0 = acc[ai][bj][m][0], v1 = acc[ai][bj][m][1];
                    const u32x4 g = *(const u32x4*)(P + r * INW + C_GS + col0 + bj * HALF);
                    const u32x4 p = *(const u32x4*)(Mg + r * DM + col0 + bj * HALF);
                    u32x4 w; w.x = cvt_pk_bf16(bflo(p.x) + v0[0] * bflo(g.x), bfhi(p.x) + v0[1] * bfhi(g.x)); w.y = cvt_pk_bf16(bflo(p.y) + v0[2] * bflo(g.y), bfhi(p.y) + v0[3] * bfhi(g.y));
                    w.z = cvt_pk_bf16(bflo(p.z) + v1[0] * bflo(g.z), bfhi(p.z) + v1[1] * bfhi(g.z)); w.w = cvt_pk_bf16(bflo(p.w) + v1[2] * bflo(g.w), bfhi(p.w) + v1[3] * bfhi(g.w));
                    *(u32x4*)(Mg + r * DM + col0 + bj * HALF) = w; } }
    }
};
struct EpiOut {
    static constexpr bool PERM = true, AFTER_DRAIN = false;
    const float* X; float* O;
    __device__ __forceinline__ void operator()(const f32x4 (&acc)[2][2][4][2], const Unit& u, int wr, int wc, int fr, int fq) const {
        const int row0 = u.pm * BM + wr * 64 + fr, col0 = u.pn * BM + wc * 32 + 8 * fq;
#pragma unroll
        for (int ai = 0; ai < 2; ++ai)
#pragma unroll
            for (int m = 0; m < 4; ++m) { const size_t off = (size_t)(row0 + ai * HALF + m * 16) * DM + col0;
#pragma unroll
                for (int bj = 0; bj < 2; ++bj) {
                    const f32x4 x0 = *(const f32x4*)(X + off + bj * HALF), x1 = *(const f32x4*)(X + off + bj * HALF + 4);
                    *(f32x4*)(O + off + bj * HALF) = x0 + acc[ai][bj][m][0]; *(f32x4*)(O + off + bj * HALF + 4) = x1 + acc[ai][bj][m][1]; } }
    }
};
}

__device__ __forceinline__ float wave_sum(float v) {
#pragma unroll
    for (int o = 1; o < 64; o <<= 1) v += __shfl_xor(v, o);
    return v;
}
__device__ __forceinline__ void p0_transpose_item(const float* W, int K, int N, bf16_t* WT, bool glu, LAS float* scr, int item, int lane) {
    const int nblk = N / 32, kb = item / nblk, nb = item % nblk, k0 = 64 * kb, n0 = 32 * nb;
#pragma unroll 8
    for (int i = 0; i < 32; ++i) { const int kk = 2 * i + (lane >> 5); scr[kk * 33 + (lane & 31)] = W[(size_t)(k0 + kk) * N + n0 + (lane & 31)]; }
    asm volatile("s_waitcnt lgkmcnt(0)" ::: "memory");
    int d0 = n0;
    if (glu) d0 = (n0 < 1024) ? (256 * (n0 >> 7) + (n0 & 127)) : (256 * ((n0 - 1024) >> 7) + 128 + (n0 & 127));
    const int c = lane & 7;
#pragma unroll
    for (int j = 0; j < 4; ++j) { const int n = (lane >> 3) + 8 * j; const LAS float* s = scr + (8 * c) * 33 + n;
        u32x4 o; o.x = pk2(s[0 * 33], s[1 * 33]); o.y = pk2(s[2 * 33], s[3 * 33]); o.z = pk2(s[4 * 33], s[5 * 33]); o.w = pk2(s[6 * 33], s[7 * 33]);
        *(u32x4*)(WT + (size_t)(d0 + n) * K + k0 + 8 * c) = o; }
    asm volatile("s_waitcnt lgkmcnt(0)" ::: "memory");
}

struct Args { const float* in[19]; float* out; unsigned char* ws; int ph_lo, ph_hi; };

__device__ __forceinline__ void p0_prologue(const Args& a, LAS unsigned char* lds, int wave, int lane) {
    LAS float* scr = (LAS float*)(lds + wave * 16384);
    const int gw = blockIdx.x * 8 + wave, NGW = gridDim.x * 8;
    constexpr int I_IN = (DM / 64) * (INW / 32), I_A = (1024 / 64) * (2048 / 32), I_O = (2048 / 64) * (2048 / 32);
    constexpr int NITEMS = I_IN + 3 * I_A + I_O;
    unsigned char* ws = a.ws;
    for (int it = gw; it < NITEMS; it += NGW) {
        int r = it;
        if (r < I_IN) { p0_transpose_item(a.in[2], DM, INW, (bf16_t*)(ws + WS_WIN), false, scr, r, lane); continue; } r -= I_IN;
        if (r < I_A) { p0_transpose_item(a.in[6], 1024, 2048, (bf16_t*)(ws + WS_WATTN), false, scr, r, lane); continue; } r -= I_A;
        if (r < I_A) { p0_transpose_item(a.in[15], 1024, 2048, (bf16_t*)(ws + WS_WGLU), true, scr, r, lane); continue; } r -= I_A;
        if (r < I_A) { p0_transpose_item(a.in[17], 1024, 2048, (bf16_t*)(ws + WS_WSSM), false, scr, r, lane); continue; } r -= I_A;
        p0_transpose_item(a.in[18], 2048, 2048, (bf16_t*)(ws + WS_WOUT), false, scr, r, lane);
    }
    const float* x = a.in[0]; const float* nw = a.in[1]; bf16_t* H = (bf16_t*)(ws + WS_H);
    f32x4 wv[8];
#pragma unroll
    for (int j = 0; j < 8; ++j) wv[j] = *((const f32x4*)nw + lane + 64 * j);
    for (int m = gw; m < MTOK; m += NGW) {
        const f32x4* xr = (const f32x4*)(x + (size_t)m * DM) + lane;
        f32x4 v[8]; float s = 0.f;
#pragma unroll
        for (int j = 0; j < 8; ++j) { v[j] = xr[64 * j]; s += (v[j].x * v[j].x + v[j].y * v[j].y) + (v[j].z * v[j].z + v[j].w * v[j].w); }
        const float rstd = rsqrtf(wave_sum(s) * (1.f / DM) + 1e-6f);
        u32x2* o8 = (u32x2*)(H + (size_t)m * DM) + lane;
#pragma unroll
        for (int j = 0; j < 8; ++j) { u32x2 o; o.x = pk2(v[j].x * rstd * wv[j].x, v[j].y * rstd * wv[j].y); o.y = pk2(v[j].z * rstd * wv[j].z, v[j].w * rstd * wv[j].w); o8[64 * j] = o; }
    }
}

constexpr int KL_STRIDE = 144, VT_STRIDE = 528, KL_BYTES = 256 * KL_STRIDE;
__device__ __forceinline__ void attn_unit(LAS unsigned char* lds, const bf16_t* P, bf16_t* AttnG, const float* qw, const float* kw, const float* sinks, int b, int blk, int g, int tid) {
    const int lane = tid & 63, w = tid >> 6, fr = lane & 15, fq = lane >> 4;
    const long base = (long)b * SEQ + (long)blk * 128;
    LAS unsigned char* Kl = lds; LAS unsigned char* Vt = lds + KL_BYTES;
    {
        const int c = tid & 7;
        const f32x4 kw0 = *(const f32x4*)(kw + 8 * c), kw1 = *(const f32x4*)(kw + 8 * c + 4);
#pragma unroll
        for (int i = 0; i < 4; ++i) { const int key = (tid >> 3) + 64 * i; const long row = base - 128 + key;
            u32x4 raw = (u32x4){0u, 0u, 0u, 0u};
            if (blk > 0 || key >= 128) raw = *(const u32x4*)(P + (size_t)row * INW + C_K + g * 64 + 8 * c);
            float f[8] = {bflo(raw.x), bfhi(raw.x), bflo(raw.y), bfhi(raw.y), bflo(raw.z), bfhi(raw.z), bflo(raw.w), bfhi(raw.w)};
            float ss = 0.f;
#pragma unroll
            for (int e = 0; e < 8; ++e) ss += f[e] * f[e];
            ss += __shfl_xor(ss, 1); ss += __shfl_xor(ss, 2); ss += __shfl_xor(ss, 4);
            const float rstd = rsqrtf(ss * (1.f / 64.f) + 1e-6f);
            u32x4 o; o.x = pk2(f[0] * rstd * kw0[0], f[1] * rstd * kw0[1]); o.y = pk2(f[2] * rstd * kw0[2], f[3] * rstd * kw0[3]);
            o.z = pk2(f[4] * rstd * kw1[0], f[5] * rstd * kw1[1]); o.w = pk2(f[6] * rstd * kw1[2], f[7] * rstd * kw1[3]);
            *(LAS u32x4*)(Kl + key * KL_STRIDE + c * 16) = o; }
    }
    {
#pragma unroll
        for (int i = 0; i < 4; ++i) { const int key = lane + 64 * i; const long row = base - 128 + key;
            u32x4 raw = (u32x4){0u, 0u, 0u, 0u};
            if (blk > 0 || key >= 128) raw = *(const u32x4*)(P + (size_t)row * INW + C_V + g * 64 + 8 * w);
            LAS unsigned short* vp = (LAS unsigned short*)(Vt + (8 * w) * VT_STRIDE + key * 2);
            vp[0 * (VT_STRIDE / 2)] = (unsigned short)(raw.x & 0xffffu); vp[1 * (VT_STRIDE / 2)] = (unsigned short)(raw.x >> 16);
            vp[2 * (VT_STRIDE / 2)] = (unsigned short)(raw.y & 0xffffu); vp[3 * (VT_STRIDE / 2)] = (unsigned short)(raw.y >> 16);
            vp[4 * (VT_STRIDE / 2)] = (unsigned short)(raw.z & 0xffffu); vp[5 * (VT_STRIDE / 2)] = (unsigned short)(raw.z >> 16);
            vp[6 * (VT_STRIDE / 2)] = (unsigned short)(raw.w & 0xffffu); vp[7 * (VT_STRIDE / 2)] = (unsigned short)(raw.w >> 16); }
    }
    __syncthreads();
    const long tok = base + 16 * w + fr;
    const f32x4 qwa0 = *(const f32x4*)(qw + 8 * fq), qwa1 = *(const f32x4*)(qw + 8 * fq + 4), qwb0 = *(const f32x4*)(qw + 32 + 8 * fq), qwb1 = *(const f32x4*)(qw + 32 + 8 * fq + 4);
#pragma unroll 1
    for (int r = 0; r < 4; ++r) {
        const int h = 4 * g + r;
        const u32x4 r0 = *(const u32x4*)(P + (size_t)tok * INW + C_Q + h * 64 + 8 * fq), r1 = *(const u32x4*)(P + (size_t)tok * INW + C_Q + h * 64 + 32 + 8 * fq);
        float q0[8] = {bflo(r0.x), bfhi(r0.x), bflo(r0.y), bfhi(r0.y), bflo(r0.z), bfhi(r0.z), bflo(r0.w), bfhi(r0.w)};
        float q1[8] = {bflo(r1.x), bfhi(r1.x), bflo(r1.y), bfhi(r1.y), bflo(r1.z), bfhi(r1.z), bflo(r1.w), bfhi(r1.w)};
        float ss = 0.f;
#pragma unroll
        for (int e = 0; e < 8; ++e) ss += q0[e] * q0[e] + q1[e] * q1[e];
        ss += __shfl_xor(ss, 16); ss += __shfl_xor(ss, 32);
        const float qs = rsqrtf(ss * (1.f / 64.f) + 1e-6f) * (0.125f * LOG2E);
        u32x4 qa, qb;
        qa.x = pk2(q0[0] * qs * qwa0[0], q0[1] * qs * qwa0[1]); qa.y = pk2(q0[2] * qs * qwa0[2], q0[3] * qs * qwa0[3]); qa.z = pk2(q0[4] * qs * qwa1[0], q0[5] * qs * qwa1[1]); qa.w = pk2(q0[6] * qs * qwa1[2], q0[7] * qs * qwa1[3]);
        qb.x = pk2(q1[0] * qs * qwb0[0], q1[1] * qs * qwb0[1]); qb.y = pk2(q1[2] * qs * qwb0[2], q1[3] * qs * qwb0[3]); qb.z = pk2(q1[4] * qs * qwb1[0], q1[5] * qs * qwb1[1]); qb.w = pk2(q1[6] * qs * qwb1[2], q1[7] * qs * qwb1[3]);
        const bf16x8 qf0 = __builtin_bit_cast(bf16x8, qa), qf1 = __builtin_bit_cast(bf16x8, qb);
        f32x4 s[9];
#pragma unroll
        for (int tt = 0; tt < 9; ++tt) { const LAS unsigned char* kp = Kl + (16 * (w + tt) + fr) * KL_STRIDE + 16 * fq;
            const bf16x8 a0 = *(const LAS bf16x8*)kp, a1 = *(const LAS bf16x8*)(kp + 64);
            f32x4 z = (f32x4){0.f, 0.f, 0.f, 0.f};
            z = __builtin_amdgcn_mfma_f32_16x16x32_bf16(a0, qf0, z, 0, 0, 0); s[tt] = __builtin_amdgcn_mfma_f32_16x16x32_bf16(a1, qf1, z, 0, 0, 0); }
        const float sink2 = sinks[h] * LOG2E; float mx = sink2;
#pragma unroll
        for (int tt = 0; tt < 9; ++tt)
#pragma unroll
            for (int j = 0; j < 4; ++j) { const int diff = 128 + fr - 16 * tt - 4 * fq - j; const bool ok = (diff >= 0) && (diff < 128) && (blk > 0 || (w + tt) >= 8);
                s[tt][j] = ok ? s[tt][j] : -INFINITY; mx = fmaxf(mx, s[tt][j]); }
        mx = fmaxf(mx, __shfl_xor(mx, 16)); mx = fmaxf(mx, __shfl_xor(mx, 32));
        float l = 0.f;
#pragma unroll
        for (int tt = 0; tt < 9; ++tt)
#pragma unroll
            for (int j = 0; j < 4; ++j) { s[tt][j] = __builtin_amdgcn_exp2f(s[tt][j] - mx); l += s[tt][j]; }
        l += __shfl_xor(l, 16); l += __shfl_xor(l, 32); l += __builtin_amdgcn_exp2f(sink2 - mx);
        const float inv = 1.f / l;
        f32x4 o[4];
#pragma unroll
        for (int dt = 0; dt < 4; ++dt) o[dt] = (f32x4){0.f, 0.f, 0.f, 0.f};
#pragma unroll
        for (int cc = 0; cc < 5; ++cc) { const int T1 = w + 2 * cc; const int T2c = (T1 + 1 > 15) ? 15 : (T1 + 1);
            u32x4 pw; pw.x = pk2(s[2 * cc][0], s[2 * cc][1]); pw.y = pk2(s[2 * cc][2], s[2 * cc][3]);
            if (cc < 4) { pw.z = pk2(s[2 * cc + 1 > 8 ? 8 : 2 * cc + 1][0], s[2 * cc + 1 > 8 ? 8 : 2 * cc + 1][1]); pw.w = pk2(s[2 * cc + 1 > 8 ? 8 : 2 * cc + 1][2], s[2 * cc + 1 > 8 ? 8 : 2 * cc + 1][3]); } else { pw.z = 0u; pw.w = 0u; }
            const bf16x8 pf = __builtin_bit_cast(bf16x8, pw);
#pragma unroll
            for (int dt = 0; dt < 4; ++dt) { const LAS unsigned char* vp = Vt + (16 * dt + fr) * VT_STRIDE;
                const u32x2 lo = *(const LAS u32x2*)(vp + (16 * T1 + 4 * fq) * 2), hi = *(const LAS u32x2*)(vp + (16 * T2c + 4 * fq) * 2);
                u32x4 av; av.x = lo.x; av.y = lo.y; av.z = hi.x; av.w = hi.y;
                o[dt] = __builtin_amdgcn_mfma_f32_16x16x32_bf16(__builtin_bit_cast(bf16x8, av), pf, o[dt], 0, 0, 0); } }
#pragma unroll
        for (int dt = 0; dt < 4; ++dt) { const int col = h * 64 + 16 * dt + 4 * fq;
            const u32x2 gt = *(const u32x2*)(P + (size_t)tok * INW + C_AG + col);
            u32x2 ov; ov.x = pk2(o[dt][0] * inv * bflo(gt.x), o[dt][1] * inv * bfhi(gt.x)); ov.y = pk2(o[dt][2] * inv * bflo(gt.y), o[dt][3] * inv * bfhi(gt.y));
            *(u32x2*)(AttnG + (size_t)tok * 1024 + col) = ov; }
    }
    __syncthreads();
}

constexpr int SW_RS = 132, SW_BYTES = 16 * SW_RS * 4;
__device__ __forceinline__ unsigned packhl(float v) { const unsigned h = f2bf(v); const float r = v - bf2f(h); return h | (f2bf(r) << 16); }
template <bool PASSB>
__device__ __forceinline__ void ssm_item(LAS unsigned char* wl, const Args& a, const bf16_t* P, float* E, bf16_t* Yg, int b, int g, int c, int lane) {
    const int fr = lane & 15, fq = lane >> 4;
    const float* A_re = a.in[7]; const float* A_im = a.in[8]; const float* log_dt = a.in[9]; const float* B_re = a.in[10]; const float* B_im = a.in[11];
    const float* C_re = a.in[12]; const float* C_im = a.in[13]; const float* D_skip = a.in[14];
    const float dt = expf(log_dt[g]);
    float abr, abi;
    { const float ar = A_re[g * 64 + lane], ai = A_im[g * 64 + lane]; const float mag = expf(dt * ar); float sn, cs; sincosf(dt * ai, &sn, &cs); abr = mag * cs; abi = mag * sn; }
    bf16x8 bq[8];
#pragma unroll
    for (int q4 = 0; q4 < 4; ++q4) { const int p = 16 * q4 + fr;
        const float ar = A_re[g * 64 + p], ai = A_im[g * 64 + p]; const float mag = expf(dt * ar); float sn, cs; sincosf(dt * ai, &sn, &cs);
        const float nr = mag * cs - 1.0f, ni = mag * sn, den = ar * ar + ai * ai; const float cfr = (nr * ar + ni * ai) / den, cfi = (ni * ar - nr * ai) / den;
        const float* br = B_re + ((size_t)(g * 64 + p)) * 16 + 8 * (fq & 1); const float* bi = B_im + ((size_t)(g * 64 + p)) * 16 + 8 * (fq & 1);
        const f32x4 br0 = *(const f32x4*)br, br1 = *(const f32x4*)(br + 4), bi0 = *(const f32x4*)bi, bi1 = *(const f32x4*)(bi + 4);
        float vre[8], vim[8];
#pragma unroll
        for (int i = 0; i < 4; ++i) { vre[i] = cfr * br0[i] - cfi * bi0[i]; vim[i] = cfr * bi0[i] + cfi * br0[i]; vre[4 + i] = cfr * br1[i] - cfi * bi1[i]; vim[4 + i] = cfr * bi1[i] + cfi * br1[i]; }
        if (fq >= 2) {
#pragma unroll
            for (int i = 0; i < 8; ++i) { vre[i] = vre[i] - bf2f(f2bf(vre[i])); vim[i] = vim[i] - bf2f(f2bf(vim[i])); } }
        u32x4 wr_, wi_; wr_.x = pk2(vre[0], vre[1]); wr_.y = pk2(vre[2], vre[3]); wr_.z = pk2(vre[4], vre[5]); wr_.w = pk2(vre[6], vre[7]);
        wi_.x = pk2(vim[0], vim[1]); wi_.y = pk2(vim[2], vim[3]); wi_.z = pk2(vim[4], vim[5]); wi_.w = pk2(vim[6], vim[7]);
        bq[q4] = __builtin_bit_cast(bf16x8, wr_); bq[4 + q4] = __builtin_bit_cast(bf16x8, wi_); }
    bf16x8 cch[4], ccl[4]; float dsk[4];
    if (PASSB) {
#pragma unroll
        for (int ks = 0; ks < 4; ++ks) { const float* cp = ((ks < 2) ? C_re : C_im) + ((size_t)(g * 16 + fr)) * 64 + 32 * (ks & 1) + 8 * fq; const float sg = (ks < 2) ? 1.f : -1.f;
            const f32x4 c0 = *(const f32x4*)cp * sg, c1 = *(const f32x4*)(cp + 4) * sg;
            float v[8] = {c0[0], c0[1], c0[2], c0[3], c1[0], c1[1], c1[2], c1[3]}; float lo[8];
#pragma unroll
            for (int i = 0; i < 8; ++i) lo[i] = v[i] - bf2f(f2bf(v[i]));
            u32x4 wh, wl_; wh.x = pk2(v[0], v[1]); wh.y = pk2(v[2], v[3]); wh.z = pk2(v[4], v[5]); wh.w = pk2(v[6], v[7]);
            wl_.x = pk2(lo[0], lo[1]); wl_.y = pk2(lo[2], lo[3]); wl_.z = pk2(lo[4], lo[5]); wl_.w = pk2(lo[6], lo[7]);
            cch[ks] = __builtin_bit_cast(bf16x8, wh); ccl[ks] = __builtin_bit_cast(bf16x8, wl_); }
#pragma unroll
        for (int j = 0; j < 4; ++j) dsk[j] = D_skip[g * 16 + 4 * fq + j];
    }
    const long tok0 = (long)b * SEQ + (long)c * 64;
    u32x4 uq[4];
#pragma unroll
    for (int st = 0; st < 4; ++st) uq[st] = *(const u32x4*)(P + (size_t)(tok0 + 16 * st + fr) * INW + C_U + 16 * g + 8 * (fq & 1));
    float sr = 0.f, si = 0.f;
    const float* Eb = E + ((size_t)(b * 64 + g) * 64) * 128;
    if (PASSB) {
        float pr = abr, pi = abi;
#pragma unroll
        for (int i = 0; i < 6; ++i) { const float nr = pr * pr - pi * pi, ni = 2.f * pr * pi; pr = nr; pi = ni; }
#pragma unroll 8
        for (int cp = 0; cp < c; ++cp) { const float er = Eb[(size_t)cp * 128 + lane], ei = Eb[(size_t)cp * 128 + 64 + lane];
            const float nr = fmaf(pr, sr, fmaf(-pi, si, er)), ni = fmaf(pr, si, fmaf(pi, sr, ei)); sr = nr; si = ni; }
    }
    LAS float* W = (LAS float*)wl; LAS unsigned* Wu = (LAS unsigned*)wl;
#pragma unroll 1
    for (int st = 0; st < 4; ++st) {
        const bf16x8 uf = __builtin_bit_cast(bf16x8, uq[st]);
#pragma unroll
        for (int nt = 0; nt < 8; ++nt) { f32x4 z = (f32x4){0.f, 0.f, 0.f, 0.f};
            z = __builtin_amdgcn_mfma_f32_16x16x32_bf16(uf, bq[nt], z, 0, 0, 0);
#pragma unroll
            for (int j = 0; j < 4; ++j) W[(4 * fq + j) * SW_RS + 16 * nt + fr] = z[j]; }
        asm volatile("s_waitcnt lgkmcnt(0)" ::: "memory");
#pragma unroll
        for (int t = 0; t < 16; ++t) { const float br = W[t * SW_RS + lane], bi = W[t * SW_RS + 64 + lane];
            const float nr = fmaf(abr, sr, fmaf(-abi, si, br)), ni = fmaf(abr, si, fmaf(abi, sr, bi)); sr = nr; si = ni;
            if (PASSB) { Wu[t * SW_RS + lane] = packhl(sr); Wu[t * SW_RS + 64 + lane] = packhl(si); } }
        if (PASSB) {
            asm volatile("s_waitcnt lgkmcnt(0)" ::: "memory");
            f32x4 y = (f32x4){0.f, 0.f, 0.f, 0.f};
#pragma unroll
            for (int ks = 0; ks < 4; ++ks) { const LAS u32x4* sp = (const LAS u32x4*)(Wu + fr * SW_RS + 32 * ks + 8 * fq); const u32x4 d0 = sp[0], d1 = sp[1];
                u32x4 ah, al;
                ah.x = (d0.x & 0xffffu) | (d0.y << 16); ah.y = (d0.z & 0xffffu) | (d0.w << 16); ah.z = (d1.x & 0xffffu) | (d1.y << 16); ah.w = (d1.z & 0xffffu) | (d1.w << 16);
                al.x = (d0.x >> 16) | (d0.y & 0xffff0000u); al.y = (d0.z >> 16) | (d0.w & 0xffff0000u); al.z = (d1.x >> 16) | (d1.y & 0xffff0000u); al.w = (d1.z >> 16) | (d1.w & 0xffff0000u);
                const bf16x8 fh = __builtin_bit_cast(bf16x8, ah), fl = __builtin_bit_cast(bf16x8, al);
                y = __builtin_amdgcn_mfma_f32_16x16x32_bf16(cch[ks], fh, y, 0, 0, 0);
                y = __builtin_amdgcn_mfma_f32_16x16x32_bf16(cch[ks], fl, y, 0, 0, 0);
                y = __builtin_amdgcn_mfma_f32_16x16x32_bf16(ccl[ks], fh, y, 0, 0, 0); }
            const size_t trow = (size_t)(tok0 + 16 * st + fr);
            const u32x2 uu = *(const u32x2*)(P + trow * INW + C_U + 16 * g + 4 * fq);
            const float y0 = fgelu_tanh(y[0] + dsk[0] * bflo(uu.x)), y1 = fgelu_tanh(y[1] + dsk[1] * bfhi(uu.x)), y2 = fgelu_tanh(y[2] + dsk[2] * bflo(uu.y)), y3 = fgelu_tanh(y[3] + dsk[3] * bfhi(uu.y));
            u32x2 ov; ov.x = pk2(y0, y1); ov.y = pk2(y2, y3);
            *(u32x2*)(Yg + trow * 1024 + 16 * g + 4 * fq) = ov;
            asm volatile("s_waitcnt lgkmcnt(0)" ::: "memory");
        }
    }
    if (!PASSB) { float* Eo = E + ((size_t)((b * 64 + g) * 64 + c)) * 128; Eo[lane] = sr; Eo[64 + lane] = si; }
}

__global__ void __launch_bounds__(512, 2) fwd(Args a) {
    extern __shared__ __attribute__((aligned(16))) unsigned char lds_raw[];
    LAS unsigned char* lds = (LAS unsigned char*)lds_raw;
    cg::grid_group grid = cg::this_grid();
    const int tid = threadIdx.x, lane = tid & 63, wave = __builtin_amdgcn_readfirstlane(tid >> 6);
    const int G = gridDim.x, bx = blockIdx.x;
    unsigned char* ws = a.ws;
    bf16_t* WinT = (bf16_t*)(ws + WS_WIN); bf16_t* WattnT = (bf16_t*)(ws + WS_WATTN); bf16_t* WgluT = (bf16_t*)(ws + WS_WGLU); bf16_t* WssmT = (bf16_t*)(ws + WS_WSSM); bf16_t* WoutT = (bf16_t*)(ws + WS_WOUT);
    bf16_t* H = (bf16_t*)(ws + WS_H); bf16_t* AttnG = (bf16_t*)(ws + WS_ATTNG); bf16_t* Yg = (bf16_t*)(ws + WS_YG); bf16_t* P = (bf16_t*)(ws + WS_P); bf16_t* Mg = (bf16_t*)(ws + WS_MG);
    bf16_t* T = (bf16_t*)((unsigned char*)a.out + OUT_T); float* E = (float*)((unsigned char*)a.out + OUT_E);
    const int lo = a.ph_lo, hi = a.ph_hi;
#define IN(k) (lo <= (k) && (k) < hi)
#define SEAM(k) do { if (IN(k) && IN((k) + 1)) grid.sync(); } while (0)

    if (IN(0)) { p0_prologue(a, lds, wave, lane); __syncthreads(); }
    SEAM(0);
    if (IN(1)) { pg8::Gemm g{H, WinT, MTOK, INW, DM}; pg8::StaticOrder S; S.init(MTOK, INW, G, bx); pg8::EpiProj Ep{P};
        pg8::gemm_phase<pg8::EpiProj, pg8::StaticOrder, true, true>(lds, g, S, Ep); }
    SEAM(1);
    if (IN(2)) {
        for (int u = bx; u < 256; u += G) { const int g = u & 3, blk = (u >> 2) & 31, b = u >> 7; attn_unit(lds, P, AttnG, a.in[3], a.in[4], a.in[5], b, blk, g, tid); }
        const int gw = bx * 8 + wave, NGW = G * 8;
        for (int it = gw; it < 8192; it += NGW) { const int c = it & 63, g = (it >> 6) & 63, b = it >> 12; ssm_item<false>(lds + wave * SW_BYTES, a, P, E, Yg, b, g, c, lane); }
        __syncthreads();
    }
    SEAM(2);
    if (IN(3)) {
        const int gw = bx * 8 + wave, NGW = G * 8;
        for (int it = gw; it < 8192; it += NGW) { const int c = it & 63, g = (it >> 6) & 63, b = it >> 12; ssm_item<true>(lds + wave * SW_BYTES, a, P, E, Yg, b, g, c, lane); }
        __syncthreads();
        pg8::Gemm g{AttnG, WattnT, MTOK, DM, 1024}; pg8::StaticOrder S; S.init(MTOK, DM, G, bx); pg8::EpiYa Ep{P, Mg};
        pg8::gemm_phase<pg8::EpiYa, pg8::StaticOrder, true, true>(lds, g, S, Ep);
    }
    SEAM(3);
    if (IN(4)) { pg8::Gemm g{Yg, WgluT, MTOK, DM, 1024}; pg8::StaticOrder S; S.init(MTOK, DM, G, bx); pg8::EpiGlu Ep{P, T, a.in[16]};
        pg8::gemm_phase<pg8::EpiGlu, pg8::StaticOrder, true, true>(lds, g, S, Ep); }
    SEAM(4);
    if (IN(5)) { pg8::Gemm g{T, WssmT, MTOK, DM, 1024}; pg8::StaticOrder S; S.init(MTOK, DM, G, bx); pg8::EpiYs Ep{P, Mg};
        pg8::gemm_phase<pg8::EpiYs, pg8::StaticOrder, true, true>(lds, g, S, Ep); }
    SEAM(5);
    if (IN(6)) { pg8::Gemm g{Mg, WoutT, MTOK, DM, DM}; pg8::StaticOrder S; S.init(MTOK, DM, G, bx); pg8::EpiOut Ep{a.in[0], a.out};
        pg8::gemm_phase<pg8::EpiOut, pg8::StaticOrder, true, true>(lds, g, S, Ep); }
#undef IN
#undef SEAM
}

extern "C" void kernel_launch(void* const* d_in, const int* in_sizes, int n_in, void* d_out, int out_size, void* d_ws, size_t ws_size, hipStream_t stream) {
    static int grid = 0;
    if (grid == 0) {
        if (n_in != 19 || out_size != MTOK * DM || ws_size < WS_END) { fprintf(stderr, "kernel_launch: unexpected shapes (n_in %d out %d ws %zu)\n", n_in, out_size, ws_size); grid = -1; return; }
        int dev = 0, cus = 0, per_cu = 0;
        (void)hipGetDevice(&dev); (void)hipDeviceGetAttribute(&cus, hipDeviceAttributeMultiprocessorCount, dev);
        (void)hipFuncSetAttribute((const void*)fwd, hipFuncAttributeMaxDynamicSharedMemorySize, LDS_BYTES);
        (void)hipOccupancyMaxActiveBlocksPerMultiprocessor(&per_cu, (const void*)fwd, 512, LDS_BYTES);
        if (per_cu < 1) per_cu = 1;
        grid = cus * per_cu;
        (void)hipGetLastError();
    }
    if (grid < 0) return;
    Args a{};
    for (int i = 0; i < 19; ++i) a.in[i] = (const float*)d_in[i];
    a.out = (float*)d_out; a.ws = (unsigned char*)d_ws;
#if MK_N_LAUNCHES == 1
    a.ph_lo = 0; a.ph_hi = 7;
    void* args[] = {&a};
    hipError_t e = hipLaunchCooperativeKernel((const void*)fwd, dim3(grid), dim3(512), args, LDS_BYTES, stream);
    if (e != hipSuccess) fprintf(stderr, "cooperative launch failed: %s (grid %d)\n", hipGetErrorString(e), grid);
#else
    for (int ph = 0; ph < 7; ++ph) { a.ph_lo = ph; a.ph_hi = ph + 1; hipLaunchKernelGGL(fwd, dim3(grid), dim3(512), LDS_BYTES, stream, a); }
#endif
}
```

```cpp
#include <hip/hip_runtime.h>
#include <hip/hip_cooperative_groups.h>
#include <cstdio>
#include <cstdint>
namespace cg = cooperative_groups;
namespace pg8 {
#define PG8_LAS __attribute__((address_space(3)))
typedef unsigned short bf16_t;
typedef short bf16x8 __attribute__((ext_vector_type(8)));
typedef float f32x4 __attribute__((ext_vector_type(4)));
typedef unsigned u32x4 __attribute__((ext_vector_type(4)));
constexpr int BM = 256, BK = 64, HALF = 128, HTB = HALF * BK * 2  , STAGE_BYTES = 8 * HTB, NXCD = 8, WGM = 8;

__host__ __device__ __forceinline__ int lds_byte(int r, int c) { const int st = (r >> 4) * 2 + (c >> 5), rr = r & 15, cc = c & 31, ob = rr * 64 + cc * 2; return st * 1024 + (ob ^ (((ob >> 9) & 1) << 5)); }
__host__ __device__ __forceinline__ void stage_rc(int b, int& R, int& C) { const int st = b / 1024, sb = b % 1024, swz = sb ^ (((sb >> 9) & 1) << 5); R = (st >> 1) * 16 + swz / 64; C = (st & 1) * 32 + (swz % 64) / 2; }
__host__ __device__ __forceinline__ int perm32(int rho) { const int n = rho >> 4, i = rho & 15; return 8 * (i >> 2) + 4 * n + (i & 3); }

struct Unit { int pm, pn; };
struct Gemm { const bf16_t* A; const bf16_t* Bt; int M, N, K; };

struct StaticOrder {
    int nM, nN, nwg, G, c;
    __host__ __device__ void init(int M, int N, int G_, int c_) { nM = M / BM; nN = N / BM; nwg = nM * nN; G = G_; c = c_; }
    __host__ __device__ bool next(int i, Unit& u) const {
        const long L = (long)i * G + c; if (L >= nwg) return false;
        int wgid = (int)L; { const int q = nwg / NXCD, r = nwg % NXCD, xcd = wgid % NXCD, off = wgid / NXCD; wgid = (xcd < r ? xcd * (q + 1) : r * (q + 1) + (xcd - r) * q) + off; }
        const int nig = WGM * nN, gid = wgid / nig, fm = gid * WGM, gsz = (nM - fm) < WGM ? (nM - fm) : WGM;
        u.pm = fm + ((wgid % nig) % gsz); u.pn = (wgid % nig) / gsz; return true;
    }
    __device__ __forceinline__ void a_ready(const Unit&) const {}
    __device__ __forceinline__ void done(const Unit&) const {}
};

__device__ __forceinline__ unsigned cvt_pk_bf16(float lo, float hi) { unsigned r; asm volatile("v_cvt_pk_bf16_f32 %0, %1, %2" : "=v"(r) : "v"(lo), "v"(hi)); return r; }
template <class Epi, class Sched, bool ALIGN_EPI = false, bool SP2 = false>
__device__ __forceinline__ void gemm_phase(PG8_LAS unsigned char* lds, const Gemm g, const Sched& S, const Epi& E) {
    const int tid = threadIdx.x, wid = __builtin_amdgcn_readfirstlane(tid >> 6), lane = tid & 63, wr = wid >> 2, wc = wid & 3, fr = lane & 15, fq = lane >> 4;
    const int K = g.K, nt = K / BK;
    unsigned voffA[2], voffB[2];
#pragma unroll
    for (int i = 0; i < 2; ++i) { int R, C; stage_rc(tid * 16 + i * 8192, R, C); const int Rb = Epi::PERM ? ((R & ~31) + perm32(R & 31)) : R;
        voffA[i] = (unsigned)(R * K + C) * 2u; voffB[i] = (unsigned)(Rb * K + C) * 2u; }
    const size_t kstep = (size_t)(BK * 2);
    const size_t hstep = (size_t)HALF * K * 2;
    const size_t tstep = 2 * hstep;
    const unsigned ldsw = (unsigned)wid * 1024u;
    const int aoff = lds_byte(wr * 64 + fr, fq * 8), boff = lds_byte(wc * 32 + fr, fq * 8);
#define PG8_SA(b, h) (((b) * 2 + (h)) * HTB)
#define PG8_SB(b, h) ((4 + (b) * 2 + (h)) * HTB)
#define PG8_STAGE(bufoff, gbase, voff) do { _Pragma("unroll") for (int _i = 0; _i < 2; ++_i) \
        __builtin_amdgcn_global_load_lds((const unsigned*)((const char*)(gbase) + (voff)[_i]), (PG8_LAS unsigned*)(lds + (bufoff) + ldsw + _i * 8192), 16, 0, 0); } while (0)
#define PG8_LDA(dst, b, h) do { _Pragma("unroll") for (int m = 0; m < 4; ++m) _Pragma("unroll") for (int k = 0; k < 2; ++k) dst[m][k] = *(const PG8_LAS bf16x8*)(lds + PG8_SA(b, h) + aoff + m * 2048 + k * 1024); } while (0)
#define PG8_LDB(dst, b, h) do { _Pragma("unroll") for (int n = 0; n < 2; ++n) _Pragma("unroll") for (int k = 0; k < 2; ++k) dst[n][k] = *(const PG8_LAS bf16x8*)(lds + PG8_SB(b, h) + boff + n * 2048 + k * 1024); } while (0)
#define PG8_MMA(ai, bj, At, Bt) do { __builtin_amdgcn_s_setprio(1); _Pragma("unroll") for (int m = 0; m < 4; ++m) _Pragma("unroll") for (int n = 0; n < 2; ++n) _Pragma("unroll") for (int k = 0; k < 2; ++k) \
        acc[ai][bj][m][n] = __builtin_amdgcn_mfma_f32_16x16x32_bf16(Bt[n][k], At[m][k], acc[ai][bj][m][n], 0, 0, 0); __builtin_amdgcn_s_setprio(0); } while (0)
#define PG8_WAIT_V(n) asm volatile("s_waitcnt vmcnt(" #n ")" ::: "memory")
#define PG8_WAIT_L(n) asm volatile("s_waitcnt lgkmcnt(" #n ")" ::: "memory")
#define PG8_BAR __builtin_amdgcn_s_barrier()
#define PG8_SCHED __builtin_amdgcn_sched_barrier(0)
    Unit cur, nxt; int ui = 0;
    if (!S.next(0, cur)) return;
    f32x4 acc[2][2][4][2];
#pragma unroll
    for (int a = 0; a < 2; ++a)
#pragma unroll
        for (int b = 0; b < 2; ++b)
#pragma unroll
            for (int m = 0; m < 4; ++m)
#pragma unroll
                for (int n = 0; n < 2; ++n) acc[a][b][m][n] = (f32x4){0.f, 0.f, 0.f, 0.f};
    bf16x8 At[4][2], B0[2][2], B1[2][2];
    const char* cA = (const char*)g.A + (size_t)cur.pm * tstep; const char* cB = (const char*)g.Bt + (size_t)cur.pn * tstep;
    S.a_ready(cur);
    if constexpr (SP2) {
        PG8_STAGE(PG8_SB(0, 0), cB, voffB); PG8_STAGE(PG8_SB(0, 1), cB + hstep, voffB); PG8_STAGE(PG8_SA(0, 0), cA, voffA); PG8_STAGE(PG8_SA(0, 1), cA + hstep, voffA);
        if (wr == 1) PG8_BAR;
        PG8_WAIT_V(2); PG8_BAR;
        PG8_STAGE(PG8_SB(1, 0), cB + kstep, voffB); PG8_STAGE(PG8_SA(1, 0), cA + kstep, voffA); PG8_STAGE(PG8_SB(1, 1), cB + hstep + kstep, voffB);
        PG8_WAIT_V(6); PG8_BAR;
    } else {
        PG8_STAGE(PG8_SB(0, 0), cB, voffB); PG8_STAGE(PG8_SA(0, 0), cA, voffA); PG8_STAGE(PG8_SB(0, 1), cB + hstep, voffB); PG8_STAGE(PG8_SA(0, 1), cA + hstep, voffA);
        if (wr == 1) PG8_BAR;
        PG8_WAIT_V(4); PG8_BAR;
        PG8_STAGE(PG8_SB(1, 0), cB + kstep, voffB); PG8_STAGE(PG8_SA(1, 0), cA + kstep, voffA); PG8_STAGE(PG8_SB(1, 1), cB + hstep + kstep, voffB);
        PG8_WAIT_V(6); PG8_BAR;
    }
    for (;;) {
        const bool has_next = S.next(ui + 1, nxt);
        const char* nA = has_next ? (const char*)g.A + (size_t)nxt.pm * tstep : cA; const char* nB = has_next ? (const char*)g.Bt + (size_t)nxt.pn * tstep : cB;
        for (int t = 0; t < nt; t += 2) {
            const bool last = (t == nt - 2);
            const char* a1 = cA + (size_t)(t + 1) * kstep;
            const char* a2 = last ? nA : cA + (size_t)(t + 2) * kstep; const char* b2 = last ? nB : cB + (size_t)(t + 2) * kstep;
            const char* a3 = a2 + kstep; const char* b3 = b2 + kstep;
            if (last && has_next) S.a_ready(nxt);
            if constexpr (SP2) {
            PG8_LDB(B0, 0, 0); PG8_LDB(B1, 0, 1); PG8_SCHED; PG8_LDA(At, 0, 0); PG8_STAGE(PG8_SA(1, 1), a1 + hstep, voffA);
            PG8_WAIT_V(8); PG8_WAIT_L(0); PG8_BAR; PG8_MMA(0, 0, At, B0); PG8_MMA(0, 1, At, B1); PG8_BAR; PG8_SCHED;
            PG8_LDA(At, 0, 1); PG8_STAGE(PG8_SB(0, 0), b2, voffB); PG8_STAGE(PG8_SB(0, 1), b2 + hstep, voffB); PG8_STAGE(PG8_SA(0, 0), a2, voffA);
            PG8_WAIT_V(8); PG8_WAIT_L(0); PG8_BAR; PG8_MMA(1, 0, At, B0); PG8_MMA(1, 1, At, B1); PG8_BAR; PG8_SCHED;
            PG8_LDB(B0, 1, 0); PG8_LDB(B1, 1, 1); PG8_SCHED; PG8_LDA(At, 1, 0); PG8_STAGE(PG8_SA(0, 1), a2 + hstep, voffA);
            PG8_WAIT_V(8); PG8_WAIT_L(0); PG8_BAR; PG8_MMA(0, 0, At, B0); PG8_MMA(0, 1, At, B1); PG8_BAR; PG8_SCHED;
            PG8_LDA(At, 1, 1); PG8_STAGE(PG8_SB(1, 0), b3, voffB); PG8_STAGE(PG8_SB(1, 1), b3 + hstep, voffB); PG8_STAGE(PG8_SA(1, 0), a3, voffA);
            PG8_WAIT_V(8); PG8_WAIT_L(0); PG8_BAR; PG8_MMA(1, 0, At, B0); PG8_MMA(1, 1, At, B1); PG8_BAR; PG8_SCHED;
            } else {
            PG8_LDB(B0, 0, 0); PG8_SCHED; PG8_LDA(At, 0, 0); PG8_STAGE(PG8_SA(1, 1), a1 + hstep, voffA);
            PG8_WAIT_L(8); PG8_BAR; PG8_WAIT_L(0); PG8_MMA(0, 0, At, B0); PG8_BAR; PG8_SCHED;
            PG8_LDB(B1, 0, 1); PG8_STAGE(PG8_SB(0, 0), b2, voffB);
            PG8_BAR; PG8_WAIT_L(0); PG8_MMA(0, 1, At, B1); PG8_BAR;
            PG8_LDA(At, 0, 1); PG8_STAGE(PG8_SA(0, 0), a2, voffA);
            PG8_BAR; PG8_WAIT_L(0); PG8_MMA(1, 0, At, B0); PG8_BAR; PG8_SCHED;
            PG8_STAGE(PG8_SB(0, 1), b2 + hstep, voffB);
            PG8_WAIT_V(6); PG8_BAR; PG8_MMA(1, 1, At, B1); PG8_BAR;
            PG8_LDB(B0, 1, 0); PG8_SCHED; PG8_LDA(At, 1, 0); PG8_STAGE(PG8_SA(0, 1), a2 + hstep, voffA);
            PG8_WAIT_L(8); PG8_BAR; PG8_WAIT_L(0); PG8_MMA(0, 0, At, B0); PG8_BAR; PG8_SCHED;
            PG8_LDB(B1, 1, 1); PG8_STAGE(PG8_SB(1, 0), b3, voffB);
            PG8_BAR; PG8_WAIT_L(0); PG8_MMA(0, 1, At, B1); PG8_BAR;
            PG8_LDA(At, 1, 1); PG8_STAGE(PG8_SA(1, 0), a3, voffA);
            PG8_BAR; PG8_WAIT_L(0); PG8_MMA(1, 0, At, B0); PG8_BAR; PG8_SCHED;
            PG8_STAGE(PG8_SB(1, 1), b3 + hstep, voffB);
            PG8_WAIT_V(6); PG8_BAR; PG8_MMA(1, 1, At, B1); PG8_BAR;
            }
        }
        if constexpr (ALIGN_EPI) { if (wr == 0) PG8_BAR; }
        if constexpr (!Epi::AFTER_DRAIN) { E(acc, cur, wr, wc, fr, fq); S.done(cur); }
        if (!has_next) break;
#pragma unroll
        for (int a = 0; a < 2; ++a)
#pragma unroll
            for (int b = 0; b < 2; ++b)
#pragma unroll
                for (int m = 0; m < 4; ++m)
#pragma unroll
                    for (int n = 0; n < 2; ++n) acc[a][b][m][n] = (f32x4){0.f, 0.f, 0.f, 0.f};
        cur = nxt; cA = nA; cB = nB; ++ui;
        if constexpr (ALIGN_EPI) { if (wr == 1) PG8_BAR; }
    }
    PG8_WAIT_V(0);
    if constexpr (!ALIGN_EPI) { if (wr == 0) PG8_BAR; }
    PG8_BAR;
    if constexpr (Epi::AFTER_DRAIN) { E.fused(acc, cur, wr, wc, fr, fq, lds, wid, lane); S.done(cur); }
#undef PG8_SA
#undef PG8_SB
#undef PG8_STAGE
#undef PG8_LDA
#undef PG8_LDB
#undef PG8_MMA
#undef PG8_WAIT_V
#undef PG8_WAIT_L
#undef PG8_BAR
#undef PG8_SCHED
}
}

#ifndef MK_N_LAUNCHES
#define MK_N_LAUNCHES 1
#endif
constexpr int DM = 2048, SEQ = 4096, MTOK = 8192, INW = 8704;
constexpr int C_Q = 0, C_K = 1024, C_V = 1280, C_AG = 1536, C_U = 2560, C_Z = 3584, C_GA = 4608, C_GS = 6656;
constexpr float LOG2E = 1.4426950408889634f;
constexpr size_t MiB = 1u << 20;
constexpr size_t WS_WIN = 0, WS_WATTN = 34 * MiB, WS_WGLU = 38 * MiB, WS_WSSM = 42 * MiB, WS_WOUT = 46 * MiB;
constexpr size_t WS_H = 54 * MiB, WS_ATTNG = 54 * MiB, WS_YG = 70 * MiB, WS_P = 86 * MiB, WS_MG = 0, WS_BAR = 222 * MiB, WS_BAR_BYTES = 16384, WS_END = 223 * MiB;
constexpr int LDS_CTL = 131072;
constexpr size_t OUT_T = 0, OUT_E = 16 * MiB;
constexpr int LDS_BYTES = 147456;

#define LAS __attribute__((address_space(3)))
typedef unsigned short bf16_t;
typedef unsigned u32x4 __attribute__((ext_vector_type(4)));
typedef unsigned u32x2 __attribute__((ext_vector_type(2)));
typedef float f32x4 __attribute__((ext_vector_type(4)));
typedef short bf16x8 __attribute__((ext_vector_type(8)));

__device__ __forceinline__ unsigned f2bf(float f) { unsigned u = __builtin_bit_cast(unsigned, f); return (u + 0x7fffu + ((u >> 16) & 1u)) >> 16; }
__device__ __forceinline__ float bf2f(unsigned b) { return __builtin_bit_cast(float, b << 16); }
__device__ __forceinline__ float bflo(unsigned w) { return __builtin_bit_cast(float, w << 16); }
__device__ __forceinline__ float bfhi(unsigned w) { return __builtin_bit_cast(float, w & 0xffff0000u); }
__device__ __forceinline__ unsigned pk2(float lo, float hi) { return pg8::cvt_pk_bf16(lo, hi); }
__device__ __forceinline__ float fsigmoid(float x) { return __builtin_amdgcn_rcpf(1.f + __expf(-x)); }
__device__ __forceinline__ float fsilu(float x) { return x * fsigmoid(x); }
__device__ __forceinline__ float fgelu_tanh(float x) { const float z = 0.7978845608028654f * (x + 0.044715f * x * x * x); return x * fsigmoid(2.f * z); }

namespace pg8 {
struct EpiProj {
    static constexpr bool PERM = true, AFTER_DRAIN = false;
    bf16_t* O;
    __device__ __forceinline__ void operator()(const f32x4 (&acc)[2][2][4][2], const Unit& u, int wr, int wc, int fr, int fq) const {
        const int pn = u.pn;
        const int act = (pn >= 18) ? 2 : (((pn >= 6 && pn < 10) || (pn >= 14 && pn < 18)) ? 1 : 0);
        const int row0 = u.pm * BM + wr * 64 + fr, col0 = pn * BM + wc * 32 + 8 * fq;
#pragma unroll
        for (int ai = 0; ai < 2; ++ai)
#pragma unroll
            for (int m = 0; m < 4; ++m) { bf16_t* rowp = O + (size_t)(row0 + ai * HALF + m * 16) * INW + col0;
#pragma unroll
                for (int bj = 0; bj < 2; ++bj) { f32x4 v0 = acc[ai][bj][m][0], v1 = acc[ai][bj][m][1];
                    if (act == 1) {
#pragma unroll
                        for (int i = 0; i < 4; ++i) { v0[i] = fsilu(v0[i]); v1[i] = fsilu(v1[i]); } }
                    else if (act == 2) {
#pragma unroll
                        for (int i = 0; i < 4; ++i) { v0[i] = fsigmoid(v0[i]); v1[i] = fsigmoid(v1[i]); } }
                    u32x4 w; w.x = cvt_pk_bf16(v0[0], v0[1]); w.y = cvt_pk_bf16(v0[2], v0[3]); w.z = cvt_pk_bf16(v1[0], v1[1]); w.w = cvt_pk_bf16(v1[2], v1[3]);
                    *(u32x4*)(rowp + bj * HALF) = w; } }
    }
};
struct EpiYa {
    static constexpr bool PERM = true, AFTER_DRAIN = false;
    const bf16_t* P; bf16_t* Mg;
    __device__ __forceinline__ void operator()(const f32x4 (&acc)[2][2][4][2], const Unit& u, int wr, int wc, int fr, int fq) const {
        const int row0 = u.pm * BM + wr * 64 + fr, col0 = u.pn * BM + wc * 32 + 8 * fq;
#pragma unroll
        for (int ai = 0; ai < 2; ++ai)
#pragma unroll
            for (int m = 0; m < 4; ++m) { const size_t r = (size_t)(row0 + ai * HALF + m * 16);
#pragma unroll
                for (int bj = 0; bj < 2; ++bj) { const f32x4 v0 = acc[ai][bj][m][0], v1 = acc[ai][bj][m][1];
                    const u32x4 g = *(const u32x4*)(P + r * INW + C_GA + col0 + bj * HALF);
                    u32x4 w; w.x = cvt_pk_bf16(v0[0] * bflo(g.x), v0[1] * bfhi(g.x)); w.y = cvt_pk_bf16(v0[2] * bflo(g.y), v0[3] * bfhi(g.y));
                    w.z = cvt_pk_bf16(v1[0] * bflo(g.z), v1[1] * bfhi(g.z)); w.w = cvt_pk_bf16(v1[2] * bflo(g.w), v1[3] * bfhi(g.w));
                    *(u32x4*)(Mg + r * DM + col0 + bj * HALF) = w; } }
    }
};
struct EpiGlu {
    static constexpr bool PERM = true, AFTER_DRAIN = false;
    const bf16_t* P; bf16_t* T; const float* bias;
    __device__ __forceinline__ void operator()(const f32x4 (&acc)[2][2][4][2], const Unit& u, int wr, int wc, int fr, int fq) const {
        const int row0 = u.pm * BM + wr * 64 + fr, col0 = u.pn * HALF + wc * 32 + 8 * fq;
        const f32x4 ba0 = *(const f32x4*)(bias + col0), ba1 = *(const f32x4*)(bias + col0 + 4);
        const f32x4 bb0 = *(const f32x4*)(bias + 1024 + col0), bb1 = *(const f32x4*)(bias + 1024 + col0 + 4);
#pragma unroll
        for (int ai = 0; ai < 2; ++ai)
#pragma unroll
            for (int m = 0; m < 4; ++m) { const size_t r = (size_t)(row0 + ai * HALF + m * 16);
                const f32x4 a0 = acc[ai][0][m][0] + ba0, a1 = acc[ai][0][m][1] + ba1, b0 = acc[ai][1][m][0] + bb0, b1 = acc[ai][1][m][1] + bb1;
                const u32x4 z = *(const u32x4*)(P + r * INW + C_Z + col0);
                u32x4 w;
                w.x = cvt_pk_bf16(a0[0] * fsigmoid(b0[0]) * bflo(z.x), a0[1] * fsigmoid(b0[1]) * bfhi(z.x));
                w.y = cvt_pk_bf16(a0[2] * fsigmoid(b0[2]) * bflo(z.y), a0[3] * fsigmoid(b0[3]) * bfhi(z.y));
                w.z = cvt_pk_bf16(a1[0] * fsigmoid(b1[0]) * bflo(z.z), a1[1] * fsigmoid(b1[1]) * bfhi(z.z));
                w.w = cvt_pk_bf16(a1[2] * fsigmoid(b1[2]) * bflo(z.w), a1[3] * fsigmoid(b1[3]) * bfhi(z.w));
                *(u32x4*)(T + r * 1024 + col0) = w; }
    }
};
struct EpiYs {
    static constexpr bool PERM = true, AFTER_DRAIN = false;
    const bf16_t* P; bf16_t* Mg;
    __device__ __forceinline__ void operator()(const f32x4 (&acc)[2][2][4][2], const Unit& u, int wr, int wc, int fr, int fq) const {
        const int row0 = u.pm * BM + wr * 64 + fr, col0 = u.pn * BM + wc * 32 + 8 * fq;
#pragma unroll
        for (int ai = 0; ai < 2; ++ai)
#pragma unroll
            for (int m = 0; m < 4; ++m) { const size_t r = (size_t)(row0 + ai * HALF + m * 16);
#pragma unroll
                for (int bj = 0; bj < 2; ++bj) { const f32x4 v0 = acc[ai][bj][m][0], v1 = acc[ai][bj][m][1];
                    const u32x4 g = *(const u32x4*)(P + r * INW + C_GS + col0 + bj * HALF);
                    const u32x4 p = *(const u32x4*)(Mg + r * DM + col0 + bj * HALF);
                    u32x4 w; w.x = cvt_pk_bf16(bflo(p.x) + v0[0] * bflo(g.x), bfhi(p.x) + v0[1] * bfhi(g.x)); w.y = cvt_pk_bf16(bflo(p.y) + v0[2] * bflo(g.y), bfhi(p.y) + v0[3] * bfhi(g.y));
                    w.z = cvt_pk_bf16(bflo(p.z) + v1[0] * bflo(g.z), bfhi(p.z) + v1[1] * bfhi(g.z)); w.w = cvt_pk_bf16(bflo(p.w) + v1[2] * bflo(g.w), bfhi(p.w) + v1[3] * bfhi(g.w));
                    *(u32x4*)(Mg + r * DM + col0 + bj * HALF) = w; } }
    }
};
struct EpiOut {
    static constexpr bool PERM = true, AFTER_DRAIN = false;
    const float* X; float* O;
    __device__ __forceinline__ void operator()(const f32x4 (&acc)[2][2][4][2], const Unit& u, int wr, int wc, int fr, int fq) const {
        const int row0 = u.pm * BM + wr * 64 + fr, col0 = u.pn * BM + wc * 32 + 8 * fq;
#pragma unroll
        for (int ai = 0; ai < 2; ++ai)
#pragma unroll
            for (int m = 0; m < 4; ++m) { const size_t off = (size_t)(row0 + ai * HALF + m * 16) * DM + col0;
#pragma unroll
                for (int bj = 0; bj < 2; ++bj) {
                    const f32x4 x0 = *(const f32x4*)(X + off + bj * HALF), x1 = *(const f32x4*)(X + off + bj * HALF + 4);
                    *(f32x4*)(O + off + bj * HALF) = x0 + acc[ai][bj][m][0]; *(f32x4*)(O + off + bj * HALF + 4) = x1 + acc[ai][bj][m][1]; } }
    }
};
}

__device__ __forceinline__ float wave_sum(float v) {
#pragma unroll
    for (int o = 1; o < 64; o <<= 1) v += __shfl_xor(v, o);
    return v;
}
__device__ __forceinline__ void p0_transpose_item(const float* W, int K, int N, bf16_t* WT, bool glu, LAS float* scr, int item, int lane) {
    const int nblk = N / 32, kb = item / nblk, nb = item % nblk, k0 = 64 * kb, n0 = 32 * nb;
#pragma unroll 8
    for (int i = 0; i < 32; ++i) { const int kk = 2 * i + (lane >> 5); scr[kk * 33 + (lane & 31)] = W[(size_t)(k0 + kk) * N + n0 + (lane & 31)]; }
    asm volatile("s_waitcnt lgkmcnt(0)" ::: "memory");
    int d0 = n0;
    if (glu) d0 = (n0 < 1024) ? (256 * (n0 >> 7) + (n0 & 127)) : (256 * ((n0 - 1024) >> 7) + 128 + (n0 & 127));
    const int c = lane & 7;
#pragma unroll
    for (int j = 0; j < 4; ++j) { const int n = (lane >> 3) + 8 * j; const LAS float* s = scr + (8 * c) * 33 + n;
        u32x4 o; o.x = pk2(s[0 * 33], s[1 * 33]); o.y = pk2(s[2 * 33], s[3 * 33]); o.z = pk2(s[4 * 33], s[5 * 33]); o.w = pk2(s[6 * 33], s[7 * 33]);
        *(u32x4*)(WT + (size_t)(d0 + n) * K + k0 + 8 * c) = o; }
    asm volatile("s_waitcnt lgkmcnt(0)" ::: "memory");
}

struct Args { const float* in[19]; float* out; unsigned char* ws; int ph_lo, ph_hi; };

__device__ __forceinline__ void p0_prologue(const Args& a, LAS unsigned char* lds, int wave, int lane) {
    LAS float* scr = (LAS float*)(lds + wave * 16384);
    const int gw = blockIdx.x * 8 + wave, NGW = gridDim.x * 8;
    constexpr int I_IN = (DM / 64) * (INW / 32), I_A = (1024 / 64) * (2048 / 32), I_O = (2048 / 64) * (2048 / 32);
    constexpr int NITEMS = I_IN + 3 * I_A + I_O;
    unsigned char* ws = a.ws;
    for (int it = gw; it < NITEMS; it += NGW) {
        int r = it;
        if (r < I_IN) { p0_transpose_item(a.in[2], DM, INW, (bf16_t*)(ws + WS_WIN), false, scr, r, lane); continue; } r -= I_IN;
        if (r < I_A) { p0_transpose_item(a.in[6], 1024, 2048, (bf16_t*)(ws + WS_WATTN), false, scr, r, lane); continue; } r -= I_A;
        if (r < I_A) { p0_transpose_item(a.in[15], 1024, 2048, (bf16_t*)(ws + WS_WGLU), true, scr, r, lane); continue; } r -= I_A;
        if (r < I_A) { p0_transpose_item(a.in[17], 1024, 2048, (bf16_t*)(ws + WS_WSSM), false, scr, r, lane); continue; } r -= I_A;
        p0_transpose_item(a.in[18], 2048, 2048, (bf16_t*)(ws + WS_WOUT), false, scr, r, lane);
    }
    const float* x = a.in[0]; const float* nw = a.in[1]; bf16_t* H = (bf16_t*)(ws + WS_H);
    f32x4 wv[8];
#pragma unroll
    for (int j = 0; j < 8; ++j) wv[j] = *((const f32x4*)nw + lane + 64 * j);
    for (int m = gw; m < MTOK; m += NGW) {
        const f32x4* xr = (const f32x4*)(x + (size_t)m * DM) + lane;
        f32x4 v[8]; float s = 0.f;
#pragma unroll
        for (int j = 0; j < 8; ++j) { v[j] = xr[64 * j]; s += (v[j].x * v[j].x + v[j].y * v[j].y) + (v[j].z * v[j].z + v[j].w * v[j].w); }
        const float rstd = rsqrtf(wave_sum(s) * (1.f / DM) + 1e-6f);
        u32x2* o8 = (u32x2*)(H + (size_t)m * DM) + lane;
#pragma unroll
        for (int j = 0; j < 8; ++j) { u32x2 o; o.x = pk2(v[j].x * rstd * wv[j].x, v[j].y * rstd * wv[j].y); o.y = pk2(v[j].z * rstd * wv[j].z, v[j].w * rstd * wv[j].w); o8[64 * j] = o; }
    }
}

constexpr int KL_STRIDE = 144, VT_STRIDE = 528, KL_BYTES = 256 * KL_STRIDE;
__device__ __forceinline__ void attn_unit(LAS unsigned char* lds, const bf16_t* P, bf16_t* AttnG, const float* qw, const float* kw, const float* sinks, int b, int blk, int g, int tid) {
    const int lane = tid & 63, w = tid >> 6, fr = lane & 15, fq = lane >> 4;
    const long base = (long)b * SEQ + (long)blk * 128;
    LAS unsigned char* Kl = lds; LAS unsigned char* Vt = lds + KL_BYTES;
    {
        const int c = tid & 7;
        const f32x4 kw0 = *(const f32x4*)(kw + 8 * c), kw1 = *(const f32x4*)(kw + 8 * c + 4);
#pragma unroll
        for (int i = 0; i < 4; ++i) { const int key = (tid >> 3) + 64 * i; const long row = base - 128 + key;
            u32x4 raw = (u32x4){0u, 0u, 0u, 0u};
            if (blk > 0 || key >= 128) raw = *(const u32x4*)(P + (size_t)row * INW + C_K + g * 64 + 8 * c);
            float f[8] = {bflo(raw.x), bfhi(raw.x), bflo(raw.y), bfhi(raw.y), bflo(raw.z), bfhi(raw.z), bflo(raw.w), bfhi(raw.w)};
            float ss = 0.f;
#pragma unroll
            for (int e = 0; e < 8; ++e) ss += f[e] * f[e];
            ss += __shfl_xor(ss, 1); ss += __shfl_xor(ss, 2); ss += __shfl_xor(ss, 4);
            const float rstd = rsqrtf(ss * (1.f / 64.f) + 1e-6f);
            u32x4 o; o.x = pk2(f[0] * rstd * kw0[0], f[1] * rstd * kw0[1]); o.y = pk2(f[2] * rstd * kw0[2], f[3] * rstd * kw0[3]);
            o.z = pk2(f[4] * rstd * kw1[0], f[5] * rstd * kw1[1]); o.w = pk2(f[6] * rstd * kw1[2], f[7] * rstd * kw1[3]);
            *(LAS u32x4*)(Kl + key * KL_STRIDE + c * 16) = o; }
    }
    {
#pragma unroll
        for (int i = 0; i < 4; ++i) { const int key = lane + 64 * i; const long row = base - 128 + key;
            u32x4 raw = (u32x4){0u, 0u, 0u, 0u};
            if (blk > 0 || key >= 128) raw = *(const u32x4*)(P + (size_t)row * INW + C_V + g * 64 + 8 * w);
            LAS unsigned short* vp = (LAS unsigned short*)(Vt + (8 * w) * VT_STRIDE + key * 2);
            vp[0 * (VT_STRIDE / 2)] = (unsigned short)(raw.x & 0xffffu); vp[1 * (VT_STRIDE / 2)] = (unsigned short)(raw.x >> 16);
            vp[2 * (VT_STRIDE / 2)] = (unsigned short)(raw.y & 0xffffu); vp[3 * (VT_STRIDE / 2)] = (unsigned short)(raw.y >> 16);
            vp[4 * (VT_STRIDE / 2)] = (unsigned short)(raw.z & 0xffffu); vp[5 * (VT_STRIDE / 2)] = (unsigned short)(raw.z >> 16);
            vp[6 * (VT_STRIDE / 2)] = (unsigned short)(raw.w & 0xffffu); vp[7 * (VT_STRIDE / 2)] = (unsigned short)(raw.w >> 16); }
    }
    __syncthreads();
    const long tok = base + 16 * w + fr;
    const f32x4 qwa0 = *(const f32x4*)(qw + 8 * fq), qwa1 = *(const f32x4*)(qw + 8 * fq + 4), qwb0 = *(const f32x4*)(qw + 32 + 8 * fq), qwb1 = *(const f32x4*)(qw + 32 + 8 * fq + 4);
#pragma unroll 1
    for (int r = 0; r < 4; ++r) {
        const int h = 4 * g + r;
        const u32x4 r0 = *(const u32x4*)(P + (size_t)tok * INW + C_Q + h * 64 + 8 * fq), r1 = *(const u32x4*)(P + (size_t)tok * INW + C_Q + h * 64 + 32 + 8 * fq);
        float q0[8] = {bflo(r0.x), bfhi(r0.x), bflo(r0.y), bfhi(r0.y), bflo(r0.z), bfhi(r0.z), bflo(r0.w), bfhi(r0.w)};
        float q1[8] = {bflo(r1.x), bfhi(r1.x), bflo(r1.y), bfhi(r1.y), bflo(r1.z), bfhi(r1.z), bflo(r1.w), bfhi(r1.w)};
        float ss = 0.f;
#pragma unroll
        for (int e = 0; e < 8; ++e) ss += q0[e] * q0[e] + q1[e] * q1[e];
        ss += __shfl_xor(ss, 16); ss += __shfl_xor(ss, 32);
        const float qs = rsqrtf(ss * (1.f / 64.f) + 1e-6f) * (0.125f * LOG2E);
        u32x4 qa, qb;
        qa.x = pk2(q0[0] * qs * qwa0[0], q0[1] * qs * qwa0[1]); qa.y = pk2(q0[2] * qs * qwa0[2], q0[3] * qs * qwa0[3]); qa.z = pk2(q0[4] * qs * qwa1[0], q0[5] * qs * qwa1[1]); qa.w = pk2(q0[6] * qs * qwa1[2], q0[7] * qs * qwa1[3]);
        qb.x = pk2(q1[0] * qs * qwb0[0], q1[1] * qs * qwb0[1]); qb.y = pk2(q1[2] * qs * qwb0[2], q1[3] * qs * qwb0[3]); qb.z = pk2(q1[4] * qs * qwb1[0], q1[5] * qs * qwb1[1]); qb.w = pk2(q1[6] * qs * qwb1[2], q1[7] * qs * qwb1[3]);
        const bf16x8 qf0 = __builtin_bit_cast(bf16x8, qa), qf1 = __builtin_bit_cast(bf16x8, qb);
        f32x4 s[9];
#pragma unroll
        for (int tt = 0; tt < 9; ++tt) { const LAS unsigned char* kp = Kl + (16 * (w + tt) + fr) * KL_STRIDE + 16 * fq;
            const bf16x8 a0 = *(const LAS bf16x8*)kp, a1 = *(const LAS bf16x8*)(kp + 64);
            f32x4 z = (f32x4){0.f, 0.f, 0.f, 0.f};
            z = __builtin_amdgcn_mfma_f32_16x16x32_bf16(a0, qf0, z, 0, 0, 0); s[tt] = __builtin_amdgcn_mfma_f32_16x16x32_bf16(a1, qf1, z, 0, 0, 0); }
        const float sink2 = sinks[h] * LOG2E; float mx = sink2;
#pragma unroll
        for (int tt = 0; tt < 9; ++tt)
#pragma unroll
            for (int j = 0; j < 4; ++j) { const int diff = 128 + fr - 16 * tt - 4 * fq - j; const bool ok = (diff >= 0) && (diff < 128) && (blk > 0 || (w + tt) >= 8);
                s[tt][j] = ok ? s[tt][j] : -INFINITY; mx = fmaxf(mx, s[tt][j]); }
        mx = fmaxf(mx, __shfl_xor(mx, 16)); mx = fmaxf(mx, __shfl_xor(mx, 32));
        float l = 0.f;
#pragma unroll
        for (int tt = 0; tt < 9; ++tt)
#pragma unroll
            for (int j = 0; j < 4; ++j) { s[tt][j] = __builtin_amdgcn_exp2f(s[tt][j] - mx); l += s[tt][j]; }
        l += __shfl_xor(l, 16); l += __shfl_xor(l, 32); l += __builtin_amdgcn_exp2f(sink2 - mx);
        const float inv = 1.f / l;
        f32x4 o[4];
#pragma unroll
        for (int dt = 0; dt < 4; ++dt) o[dt] = (f32x4){0.f, 0.f, 0.f, 0.f};
#pragma unroll
        for (int cc = 0; cc < 5; ++cc) { const int T1 = w + 2 * cc; const int T2c = (T1 + 1 > 15) ? 15 : (T1 + 1);
            u32x4 pw; pw.x = pk2(s[2 * cc][0], s[2 * cc][1]); pw.y = pk2(s[2 * cc][2], s[2 * cc][3]);
            if (cc < 4) { pw.z = pk2(s[2 * cc + 1 > 8 ? 8 : 2 * cc + 1][0], s[2 * cc + 1 > 8 ? 8 : 2 * cc + 1][1]); pw.w = pk2(s[2 * cc + 1 > 8 ? 8 : 2 * cc + 1][2], s[2 * cc + 1 > 8 ? 8 : 2 * cc + 1][3]); } else { pw.z = 0u; pw.w = 0u; }
            const bf16x8 pf = __builtin_bit_cast(bf16x8, pw);
#pragma unroll
            for (int dt = 0; dt < 4; ++dt) { const LAS unsigned char* vp = Vt + (16 * dt + fr) * VT_STRIDE;
                const u32x2 lo = *(const LAS u32x2*)(vp + (16 * T1 + 4 * fq) * 2), hi = *(const LAS u32x2*)(vp + (16 * T2c + 4 * fq) * 2);
                u32x4 av; av.x = lo.x; av.y = lo.y; av.z = hi.x; av.w = hi.y;
                o[dt] = __builtin_amdgcn_mfma_f32_16x16x32_bf16(__builtin_bit_cast(bf16x8, av), pf, o[dt], 0, 0, 0); } }
#pragma unroll
        for (int dt = 0; dt < 4; ++dt) { const int col = h * 64 + 16 * dt + 4 * fq;
            const u32x2 gt = *(const u32x2*)(P + (size_t)tok * INW + C_AG + col);
            u32x2 ov; ov.x = pk2(o[dt][0] * inv * bflo(gt.x), o[dt][1] * inv * bfhi(gt.x)); ov.y = pk2(o[dt][2] * inv * bflo(gt.y), o[dt][3] * inv * bfhi(gt.y));
            *(u32x2*)(AttnG + (size_t)tok * 1024 + col) = ov; }
    }
    __syncthreads();
}

constexpr int SW_RS = 132, SW_BYTES = 16 * SW_RS * 4;
__device__ __forceinline__ unsigned packhl(float v) { const unsigned h = f2bf(v); const float r = v - bf2f(h); return h | (f2bf(r) << 16); }
template <bool PASSB>
__device__ __forceinline__ void ssm_item(LAS unsigned char* wl, const Args& a, const bf16_t* P, float* E, bf16_t* Yg, int b, int g, int c, int lane) {
    const int fr = lane & 15, fq = lane >> 4;
    const float* A_re = a.in[7]; const float* A_im = a.in[8]; const float* log_dt = a.in[9]; const float* B_re = a.in[10]; const float* B_im = a.in[11];
    const float* C_re = a.in[12]; const float* C_im = a.in[13]; const float* D_skip = a.in[14];
    const float dt = expf(log_dt[g]);
    float abr, abi;
    { const float ar = A_re[g * 64 + lane], ai = A_im[g * 64 + lane]; const float mag = expf(dt * ar); float sn, cs; sincosf(dt * ai, &sn, &cs); abr = mag * cs; abi = mag * sn; }
    bf16x8 bq[8];
#pragma unroll
    for (int q4 = 0; q4 < 4; ++q4) { const int p = 16 * q4 + fr;
        const float ar = A_re[g * 64 + p], ai = A_im[g * 64 + p]; const float mag = expf(dt * ar); float sn, cs; sincosf(dt * ai, &sn, &cs);
        const float nr = mag * cs - 1.0f, ni = mag * sn, den = ar * ar + ai * ai; const float cfr = (nr * ar + ni * ai) / den, cfi = (ni * ar - nr * ai) / den;
        const float* br = B_re + ((size_t)(g * 64 + p)) * 16 + 8 * (fq & 1); const float* bi = B_im + ((size_t)(g * 64 + p)) * 16 + 8 * (fq & 1);
        const f32x4 br0 = *(const f32x4*)br, br1 = *(const f32x4*)(br + 4), bi0 = *(const f32x4*)bi, bi1 = *(const f32x4*)(bi + 4);
        float vre[8], vim[8];
#pragma unroll
        for (int i = 0; i < 4; ++i) { vre[i] = cfr * br0[i] - cfi * bi0[i]; vim[i] = cfr * bi0[i] + cfi * br0[i]; vre[4 + i] = cfr * br1[i] - cfi * bi1[i]; vim[4 + i] = cfr * bi1[i] + cfi * br1[i]; }
        if (fq >= 2) {
#pragma unroll
            for (int i = 0; i < 8; ++i) { vre[i] = vre[i] - bf2f(f2bf(vre[i])); vim[i] = vim[i] - bf2f(f2bf(vim[i])); } }
        u32x4 wr_, wi_; wr_.x = pk2(vre[0], vre[1]); wr_.y = pk2(vre[2], vre[3]); wr_.z = pk2(vre[4], vre[5]); wr_.w = pk2(vre[6], vre[7]);
        wi_.x = pk2(vim[0], vim[1]); wi_.y = pk2(vim[2], vim[3]); wi_.z = pk2(vim[4], vim[5]); wi_.w = pk2(vim[6], vim[7]);
        bq[q4] = __builtin_bit_cast(bf16x8, wr_); bq[4 + q4] = __builtin_bit_cast(bf16x8, wi_); }
    bf16x8 cch[4], ccl[4]; float dsk[4];
    if (PASSB) {
#pragma unroll
        for (int ks = 0; ks < 4; ++ks) { const float* cp = ((ks < 2) ? C_re : C_im) + ((size_t)(g * 16 + fr)) * 64 + 32 * (ks & 1) + 8 * fq; const float sg = (ks < 2) ? 1.f : -1.f;
            const f32x4 c0 = *(const f32x4*)cp * sg, c1 = *(const f32x4*)(cp + 4) * sg;
            float v[8] = {c0[0], c0[1], c0[2], c0[3], c1[0], c1[1], c1[2], c1[3]}; float lo[8];
#pragma unroll
            for (int i = 0; i < 8; ++i) lo[i] = v[i] - bf2f(f2bf(v[i]));
            u32x4 wh, wl_; wh.x = pk2(v[0], v[1]); wh.y = pk2(v[2], v[3]); wh.z = pk2(v[4], v[5]); wh.w = pk2(v[6], v[7]);
            wl_.x = pk2(lo[0], lo[1]); wl_.y = pk2(lo[2], lo[3]); wl_.z = pk2(lo[4], lo[5]); wl_.w = pk2(lo[6], lo[7]);
            cch[ks] = __builtin_bit_cast(bf16x8, wh); ccl[ks] = __builtin_bit_cast(bf16x8, wl_); }
#pragma unroll
        for (int j = 0; j < 4; ++j) dsk[j] = D_skip[g * 16 + 4 * fq + j];
    }
    const long tok0 = (long)b * SEQ + (long)c * 64;
    u32x4 uq[4];
#pragma unroll
    for (int st = 0; st < 4; ++st) uq[st] = *(const u32x4*)(P + (size_t)(tok0 + 16 * st + fr) * INW + C_U + 16 * g + 8 * (fq & 1));
    float sr = 0.f, si = 0.f;
    const float* Eb = E + ((size_t)(b * 64 + g) * 64) * 128;
    if (PASSB) {
        float pr = abr, pi = abi;
#pragma unroll
        for (int i = 0; i < 6; ++i) { const float nr = pr * pr - pi * pi, ni = 2.f * pr * pi; pr = nr; pi = ni; }
#pragma unroll 8
        for (int cp = 0; cp < c; ++cp) { const float er = Eb[(size_t)cp * 128 + lane], ei = Eb[(size_t)cp * 128 + 64 + lane];
            const float nr = fmaf(pr, sr, fmaf(-pi, si, er)), ni = fmaf(pr, si, fmaf(pi, sr, ei)); sr = nr; si = ni; }
    }
    LAS float* W = (LAS float*)wl; LAS unsigned* Wu = (LAS unsigned*)wl;
#pragma unroll 1
    for (int st = 0; st < 4; ++st) {
        const bf16x8 uf = __builtin_bit_cast(bf16x8, uq[st]);
#pragma unroll
        for (int nt = 0; nt < 8; ++nt) { f32x4 z = (f32x4){0.f, 0.f, 0.f, 0.f};
            z = __builtin_amdgcn_mfma_f32_16x16x32_bf16(uf, bq[nt], z, 0, 0, 0);
#pragma unroll
            for (int j = 0; j < 4; ++j) W[(4 * fq + j) * SW_RS + 16 * nt + fr] = z[j]; }
        asm volatile("s_waitcnt lgkmcnt(0)" ::: "memory");
#pragma unroll
        for (int t = 0; t < 16; ++t) { const float br = W[t * SW_RS + lane], bi = W[t * SW_RS + 64 + lane];
            const float nr = fmaf(abr, sr, fmaf(-abi, si, br)), ni = fmaf(abr, si, fmaf(abi, sr, bi)); sr = nr; si = ni;
            if (PASSB) { Wu[t * SW_RS + lane] = packhl(sr); Wu[t * SW_RS + 64 + lane] = packhl(si); } }
        if (PASSB) {
            asm volatile("s_waitcnt lgkmcnt(0)" ::: "memory");
            f32x4 y = (f32x4){0.f, 0.f, 0.f, 0.f};
#pragma unroll
            for (int ks = 0; ks < 4; ++ks) { const LAS u32x4* sp = (const LAS u32x4*)(Wu + fr * SW_RS + 32 * ks + 8 * fq); const u32x4 d0 = sp[0], d1 = sp[1];
                u32x4 ah, al;
                ah.x = (d0.x & 0xffffu) | (d0.y << 16); ah.y = (d0.z & 0xffffu) | (d0.w << 16); ah.z = (d1.x & 0xffffu) | (d1.y << 16); ah.w = (d1.z & 0xffffu) | (d1.w << 16);
                al.x = (d0.x >> 16) | (d0.y & 0xffff0000u); al.y = (d0.z >> 16) | (d0.w & 0xffff0000u); al.z = (d1.x >> 16) | (d1.y & 0xffff0000u); al.w = (d1.z >> 16) | (d1.w & 0xffff0000u);
                const bf16x8 fh = __builtin_bit_cast(bf16x8, ah), fl = __builtin_bit_cast(bf16x8, al);
                y = __builtin_amdgcn_mfma_f32_16x16x32_bf16(cch[ks], fh, y, 0, 0, 0);
                y = __builtin_amdgcn_mfma_f32_16x16x32_bf16(cch[ks], fl, y, 0, 0, 0);
                y = __builtin_amdgcn_mfma_f32_16x16x32_bf16(ccl[ks], fh, y, 0, 0, 0); }
            const size_t trow = (size_t)(tok0 + 16 * st + fr);
            const u32x2 uu = *(const u32x2*)(P + trow * INW + C_U + 16 * g + 4 * fq);
            const float y0 = fgelu_tanh(y[0] + dsk[0] * bflo(uu.x)), y1 = fgelu_tanh(y[1] + dsk[1] * bfhi(uu.x)), y2 = fgelu_tanh(y[2] + dsk[2] * bflo(uu.y)), y3 = fgelu_tanh(y[3] + dsk[3] * bfhi(uu.y));
            u32x2 ov; ov.x = pk2(y0, y1); ov.y = pk2(y2, y3);
            *(u32x2*)(Yg + trow * 1024 + 16 * g + 4 * fq) = ov;
            asm volatile("s_waitcnt lgkmcnt(0)" ::: "memory");
        }
    }
    if (!PASSB) { float* Eo = E + ((size_t)((b * 64 + g) * 64 + c)) * 128; Eo[lane] = sr; Eo[64 + lane] = si; }
}

#define XB_TMO      128
#define XB_XCNT(j)  (256  + 64 * (j))
#define XB_XSUB(j)  (1280 + 64 * (j))
#define XB_XGEN(j)  (2304 + 64 * (j))
#define XB_TOP      3328
#define XB_TOPGEN   3392
#define XCD_BAR_WORDS 3456
#define XB_SPIN_CAP (1u << 18)

__device__ __forceinline__ unsigned xb_ld(unsigned* p)              { return __hip_atomic_load(p, __ATOMIC_RELAXED, __HIP_MEMORY_SCOPE_AGENT); }
__device__ __forceinline__ unsigned xb_add(unsigned* p, unsigned v) { return __hip_atomic_fetch_add(p, v, __ATOMIC_RELAXED, __HIP_MEMORY_SCOPE_AGENT); }
__device__ __forceinline__ unsigned xb_xcc_id() { return (unsigned)__builtin_amdgcn_s_getreg((3 << 11) | 20) & 0xFu; }
#define XB_SPIN(cond, bar) do { unsigned _sp = 0; while (cond) { __builtin_amdgcn_s_sleep(1); \
    if ((++_sp & 255u) == 0u) { if (xb_ld(&(bar)[XB_TMO])) break; if (_sp > XB_SPIN_CAP) { atomicAdd(&(bar)[XB_TMO], 1u); break; } } } } while (0)

struct XcdBarrier {
    unsigned* bar; unsigned x;
    volatile LAS unsigned* st;
};

__device__ __forceinline__ XcdBarrier xcd_barrier_post(unsigned* bar, volatile LAS unsigned* st) {
    XcdBarrier b; b.bar = bar; b.x = xb_xcc_id(); b.st = st;
    if (threadIdx.x == 0) (void)xb_add(&bar[XB_XCNT(b.x)], 1u);
    return b;
}
__device__ __forceinline__ void xcd_barrier_complete(unsigned* bar, unsigned x, unsigned& nloc, unsigned& nx) {
    const unsigned G = gridDim.x * gridDim.y * gridDim.z;
    unsigned sum, cnt, mine, sp = 0u;
    for (;;) {
        sum = 0u; cnt = 0u; mine = 0u;
#pragma unroll
        for (unsigned j = 0; j < 16; ++j) { const unsigned c = xb_ld(&bar[XB_XCNT(j)]); sum += c; cnt += (c > 0u) ? 1u : 0u; mine = (j == x) ? c : mine; }
        if (sum == G) break;
        __builtin_amdgcn_s_sleep(1);
        if ((++sp & 255u) == 0u) { if (xb_ld(&bar[XB_TMO])) break; if (sp > XB_SPIN_CAP) { atomicAdd(&bar[XB_TMO], 1u); break; } }
    }
    nloc = mine > 0u ? mine : 1u; nx = cnt > 0u ? cnt : 1u;
}

__device__ __forceinline__ void xcd_barrier(const XcdBarrier& b) {
    asm volatile("s_waitcnt vmcnt(0)" ::: "memory");
    __syncthreads();
    if (threadIdx.x == 0) {
        unsigned* bar = b.bar;
        __builtin_amdgcn_s_waitcnt(0);
        unsigned nloc = b.st[0], nx = b.st[1];
        if (nloc == 0u) { xcd_barrier_complete(bar, b.x, nloc, nx); b.st[0] = nloc; b.st[1] = nx; }
        const unsigned old = xb_add(&bar[XB_XSUB(b.x)], 1u);
        const unsigned gen = old / nloc;
        if (old + 1u == (gen + 1u) * nloc) {
            __builtin_amdgcn_fence(__ATOMIC_RELEASE, "agent");
            asm volatile("s_waitcnt vmcnt(0)" ::: "memory");
            const unsigned og = xb_add(&bar[XB_TOP], 1u);
            const unsigned tg = og / nx;
            if (og + 1u == (tg + 1u) * nx) xb_add(&bar[XB_TOPGEN], 1u);
            else XB_SPIN(xb_ld(&bar[XB_TOPGEN]) == tg, bar);
            __builtin_amdgcn_fence(__ATOMIC_ACQUIRE, "agent");
            xb_add(&bar[XB_XGEN(b.x)], 1u);
            asm volatile("s_waitcnt vmcnt(0)" ::: "memory");
        } else {
            XB_SPIN(xb_ld(&bar[XB_XGEN(b.x)]) == gen, bar);
            __builtin_amdgcn_fence(__ATOMIC_ACQUIRE, "agent");
            asm volatile("s_waitcnt vmcnt(0)" ::: "memory");
        }
    }
    __syncthreads();
}

__global__ void __launch_bounds__(512, 2) fwd(Args a) {
    extern __shared__ __attribute__((aligned(16))) unsigned char lds_raw[];
    LAS unsigned char* lds = (LAS unsigned char*)lds_raw;
    cg::grid_group grid = cg::this_grid();
    const int tid = threadIdx.x, lane = tid & 63, wave = __builtin_amdgcn_readfirstlane(tid >> 6);
    const int G = gridDim.x, bx = blockIdx.x;
    unsigned char* ws = a.ws;
    bf16_t* WinT = (bf16_t*)(ws + WS_WIN); bf16_t* WattnT = (bf16_t*)(ws + WS_WATTN); bf16_t* WgluT = (bf16_t*)(ws + WS_WGLU); bf16_t* WssmT = (bf16_t*)(ws + WS_WSSM); bf16_t* WoutT = (bf16_t*)(ws + WS_WOUT);
    bf16_t* H = (bf16_t*)(ws + WS_H); bf16_t* AttnG = (bf16_t*)(ws + WS_ATTNG); bf16_t* Yg = (bf16_t*)(ws + WS_YG); bf16_t* P = (bf16_t*)(ws + WS_P); bf16_t* Mg = (bf16_t*)(ws + WS_MG);
    bf16_t* T = (bf16_t*)((unsigned char*)a.out + OUT_T); float* E = (float*)((unsigned char*)a.out + OUT_E);
    const int lo = a.ph_lo, hi = a.ph_hi;
#define IN(k) (lo <= (k) && (k) < hi)
    if (tid < 16) ((LAS unsigned*)(lds + LDS_CTL))[tid] = 0u;
    __syncthreads();
    XcdBarrier bar = xcd_barrier_post((unsigned*)(ws + WS_BAR), (volatile LAS unsigned*)(lds + LDS_CTL) + 8);
    if (hi == 99) grid.sync();
#define SEAM(k) do { if (IN(k) && IN((k) + 1)) xcd_barrier(bar); } while (0)

    if (IN(0)) { p0_prologue(a, lds, wave, lane); __syncthreads(); }
    SEAM(0);
    if (IN(1)) { pg8::Gemm g{H, WinT, MTOK, INW, DM}; pg8::StaticOrder S; S.init(MTOK, INW, G, bx); pg8::EpiProj Ep{P};
        pg8::gemm_phase<pg8::EpiProj, pg8::StaticOrder, true, true>(lds, g, S, Ep); }
    SEAM(1);
    if (IN(2)) {
        for (int u = bx; u < 256; u += G) { const int g = u & 3, blk = (u >> 2) & 31, b = u >> 7; attn_unit(lds, P, AttnG, a.in[3], a.in[4], a.in[5], b, blk, g, tid); }
        const int gw = bx * 8 + wave, NGW = G * 8;
        for (int it = gw; it < 8192; it += NGW) { const int c = it & 63, g = (it >> 6) & 63, b = it >> 12; ssm_item<false>(lds + wave * SW_BYTES, a, P, E, Yg, b, g, c, lane); }
        __syncthreads();
    }
    SEAM(2);
    if (IN(3)) {
        const int gw = bx * 8 + wave, NGW = G * 8;
        for (int it = gw; it < 8192; it += NGW) { const int c = it & 63, g = (it >> 6) & 63, b = it >> 12; ssm_item<true>(lds + wave * SW_BYTES, a, P, E, Yg, b, g, c, lane); }
        __syncthreads();
        pg8::Gemm g{AttnG, WattnT, MTOK, DM, 1024}; pg8::StaticOrder S; S.init(MTOK, DM, G, bx); pg8::EpiYa Ep{P, Mg};
        pg8::gemm_phase<pg8::EpiYa, pg8::StaticOrder, true, true>(lds, g, S, Ep);
    }
    SEAM(3);
    if (IN(4)) { pg8::Gemm g{Yg, WgluT, MTOK, DM, 1024}; pg8::StaticOrder S; S.init(MTOK, DM, G, bx); pg8::EpiGlu Ep{P, T, a.in[16]};
        pg8::gemm_phase<pg8::EpiGlu, pg8::StaticOrder, true, true>(lds, g, S, Ep); }
    SEAM(4);
    if (IN(5)) { pg8::Gemm g{T, WssmT, MTOK, DM, 1024}; pg8::StaticOrder S; S.init(MTOK, DM, G, bx); pg8::EpiYs Ep{P, Mg};
        pg8::gemm_phase<pg8::EpiYs, pg8::StaticOrder, true, true>(lds, g, S, Ep); }
    SEAM(5);
    if (IN(6)) { pg8::Gemm g{Mg, WoutT, MTOK, DM, DM}; pg8::StaticOrder S; S.init(MTOK, DM, G, bx); pg8::EpiOut Ep{a.in[0], a.out};
        pg8::gemm_phase<pg8::EpiOut, pg8::StaticOrder, true, true>(lds, g, S, Ep); }
#undef IN
#undef SEAM
}

extern "C" void kernel_launch(void* const* d_in, const int* in_sizes, int n_in, void* d_out, int out_size, void* d_ws, size_t ws_size, hipStream_t stream) {
    static int grid = 0;
    if (grid == 0) {
        if (n_in != 19 || out_size != MTOK * DM || ws_size < WS_END) { fprintf(stderr, "kernel_launch: unexpected shapes (n_in %d out %d ws %zu)\n", n_in, out_size, ws_size); grid = -1; return; }
        int dev = 0, cus = 0, per_cu = 0;
        (void)hipGetDevice(&dev); (void)hipDeviceGetAttribute(&cus, hipDeviceAttributeMultiprocessorCount, dev);
        (void)hipFuncSetAttribute((const void*)fwd, hipFuncAttributeMaxDynamicSharedMemorySize, LDS_BYTES);
        (void)hipOccupancyMaxActiveBlocksPerMultiprocessor(&per_cu, (const void*)fwd, 512, LDS_BYTES);
        if (per_cu < 1) per_cu = 1;
        grid = cus * per_cu;
        (void)hipGetLastError();
    }
    if (grid < 0) return;
    if (MK_N_LAUNCHES == 1) (void)hipMemsetAsync((unsigned char*)d_ws + WS_BAR, 0, WS_BAR_BYTES, stream);
    Args a{};
    for (int i = 0; i < 19; ++i) a.in[i] = (const float*)d_in[i];
    a.out = (float*)d_out; a.ws = (unsigned char*)d_ws;
#if MK_N_LAUNCHES == 1
    a.ph_lo = 0; a.ph_hi = 7;
    void* args[] = {&a};
    hipError_t e = hipLaunchCooperativeKernel((const void*)fwd, dim3(grid), dim3(512), args, LDS_BYTES, stream);
    if (e != hipSuccess) fprintf(stderr, "cooperative launch failed: %s (grid %d)\n", hipGetErrorString(e), grid);
#else
    for (int ph = 0; ph < 7; ++ph) { a.ph_lo = ph; a.ph_hi = ph + 1; hipLaunchKernelGGL(fwd, dim3(grid), dim3(512), LDS_BYTES, stream, a); }
#endif
}
```

```cpp
#include <hip/hip_runtime.h>
#include <hip/hip_cooperative_groups.h>
#include <cstdio>
#include <cstdint>
namespace cg = cooperative_groups;
namespace pg8 {
#define PG8_LAS __attribute__((address_space(3)))
typedef unsigned short bf16_t;
typedef short bf16x8 __attribute__((ext_vector_type(8)));
typedef float f32x4 __attribute__((ext_vector_type(4)));
typedef unsigned u32x4 __attribute__((ext_vector_type(4)));
constexpr int BM = 256, BK = 64, HALF = 128, HTB = HALF * BK * 2  , STAGE_BYTES = 8 * HTB, NXCD = 8, WGM = 8;

__host__ __device__ __forceinline__ int lds_byte(int r, int c) { const int st = (r >> 4) * 2 + (c >> 5), rr = r & 15, cc = c & 31, ob = rr * 64 + cc * 2; return st * 1024 + (ob ^ (((ob >> 9) & 1) << 5)); }
__host__ __device__ __forceinline__ void stage_rc(int b, int& R, int& C) { const int st = b / 1024, sb = b % 1024, swz = sb ^ (((sb >> 9) & 1) << 5); R = (st >> 1) * 16 + swz / 64; C = (st & 1) * 32 + (swz % 64) / 2; }
__host__ __device__ __forceinline__ int perm32(int rho) { const int n = rho >> 4, i = rho & 15; return 8 * (i >> 2) + 4 * n + (i & 3); }

struct Unit { int pm, pn; };
struct Gemm { const bf16_t* A; const bf16_t* Bt; int M, N, K; };

struct StaticOrder {
    int nM, nN, nwg, G, c;
    __host__ __device__ void init(int M, int N, int G_, int c_) { nM = M / BM; nN = N / BM; nwg = nM * nN; G = G_; c = c_; }
    __host__ __device__ bool next(int i, Unit& u) const {
        const long L = (long)i * G + c; if (L >= nwg) return false;
        int wgid = (int)L; { const int q = nwg / NXCD, r = nwg % NXCD, xcd = wgid % NXCD, off = wgid / NXCD; wgid = (xcd < r ? xcd * (q + 1) : r * (q + 1) + (xcd - r) * q) + off; }
        const int nig = WGM * nN, gid = wgid / nig, fm = gid * WGM, gsz = (nM - fm) < WGM ? (nM - fm) : WGM;
        u.pm = fm + ((wgid % nig) % gsz); u.pn = (wgid % nig) / gsz; return true;
    }
    __device__ __forceinline__ void a_ready(const Unit&) const {}
    __device__ __forceinline__ void done(const Unit&) const {}
};

__device__ __forceinline__ unsigned cvt_pk_bf16(float lo, float hi) { unsigned r; asm volatile("v_cvt_pk_bf16_f32 %0, %1, %2" : "=v"(r) : "v"(lo), "v"(hi)); return r; }
template <class Epi, class Sched, bool ALIGN_EPI = false, bool SP2 = false>
__device__ __forceinline__ void gemm_phase(PG8_LAS unsigned char* lds, const Gemm g, const Sched& S, const Epi& E) {
    const int tid = threadIdx.x, wid = __builtin_amdgcn_readfirstlane(tid >> 6), lane = tid & 63, wr = wid >> 2, wc = wid & 3, fr = lane & 15, fq = lane >> 4;
    const int K = g.K, nt = K / BK;
    unsigned voffA[2], voffB[2];
#pragma unroll
    for (int i = 0; i < 2; ++i) { int R, C; stage_rc(tid * 16 + i * 8192, R, C); const int Rb = Epi::PERM ? ((R & ~31) + perm32(R & 31)) : R;
        voffA[i] = (unsigned)(R * K + C) * 2u; voffB[i] = (unsigned)(Rb * K + C) * 2u; }
    const size_t kstep = (size_t)(BK * 2);
    const size_t hstep = (size_t)HALF * K * 2;
    const size_t tstep = 2 * hstep;
    const unsigned ldsw = (unsigned)wid * 1024u;
    const int aoff = lds_byte(wr * 64 + fr, fq * 8), boff = lds_byte(wc * 32 + fr, fq * 8);
#define PG8_SA(b, h) (((b) * 2 + (h)) * HTB)
#define PG8_SB(b, h) ((4 + (b) * 2 + (h)) * HTB)
#define PG8_STAGE(bufoff, gbase, voff) do { _Pragma("unroll") for (int _i = 0; _i < 2; ++_i) \
        __builtin_amdgcn_global_load_lds((const unsigned*)((const char*)(gbase) + (voff)[_i]), (PG8_LAS unsigned*)(lds + (bufoff) + ldsw + _i * 8192), 16, 0, 0); } while (0)
#define PG8_LDA(dst, b, h) do { _Pragma("unroll") for (int m = 0; m < 4; ++m) _Pragma("unroll") for (int k = 0; k < 2; ++k) dst[m][k] = *(const PG8_LAS bf16x8*)(lds + PG8_SA(b, h) + aoff + m * 2048 + k * 1024); } while (0)
#define PG8_LDB(dst, b, h) do { _Pragma("unroll") for (int n = 0; n < 2; ++n) _Pragma("unroll") for (int k = 0; k < 2; ++k) dst[n][k] = *(const PG8_LAS bf16x8*)(lds + PG8_SB(b, h) + boff + n * 2048 + k * 1024); } while (0)
#define PG8_MMA(ai, bj, At, Bt) do { __builtin_amdgcn_s_setprio(1); _Pragma("unroll") for (int m = 0; m < 4; ++m) _Pragma("unroll") for (int n = 0; n < 2; ++n) _Pragma("unroll") for (int k = 0; k < 2; ++k) \
        acc[ai][bj][m][n] = __builtin_amdgcn_mfma_f32_16x16x32_bf16(Bt[n][k], At[m][k], acc[ai][bj][m][n], 0, 0, 0); __builtin_amdgcn_s_setprio(0); } while (0)
#define PG8_WAIT_V(n) asm volatile("s_waitcnt vmcnt(" #n ")" ::: "memory")
#define PG8_WAIT_L(n) asm volatile("s_waitcnt lgkmcnt(" #n ")" ::: "memory")
#define PG8_BAR __builtin_amdgcn_s_barrier()
#define PG8_SCHED __builtin_amdgcn_sched_barrier(0)
    Unit cur, nxt; int ui = 0;
    if (!S.next(0, cur)) return;
    f32x4 acc[2][2][4][2];
#pragma unroll
    for (int a = 0; a < 2; ++a)
#pragma unroll
        for (int b = 0; b < 2; ++b)
#pragma unroll
            for (int m = 0; m < 4; ++m)
#pragma unroll
                for (int n = 0; n < 2; ++n) acc[a][b][m][n] = (f32x4){0.f, 0.f, 0.f, 0.f};
    bf16x8 At[4][2], B0[2][2], B1[2][2];
    const char* cA = (const char*)g.A + (size_t)cur.pm * tstep; const char* cB = (const char*)g.Bt + (size_t)cur.pn * tstep;
    S.a_ready(cur);
    if constexpr (SP2) {
        PG8_STAGE(PG8_SB(0, 0), cB, voffB); PG8_STAGE(PG8_SB(0, 1), cB + hstep, voffB); PG8_STAGE(PG8_SA(0, 0), cA, voffA); PG8_STAGE(PG8_SA(0, 1), cA + hstep, voffA);
        if (wr == 1) PG8_BAR;
        PG8_WAIT_V(2); PG8_BAR;
        PG8_STAGE(PG8_SB(1, 0), cB + kstep, voffB); PG8_STAGE(PG8_SA(1, 0), cA + kstep, voffA); PG8_STAGE(PG8_SB(1, 1), cB + hstep + kstep, voffB);
        PG8_WAIT_V(6); PG8_BAR;
    } else {
        PG8_STAGE(PG8_SB(0, 0), cB, voffB); PG8_STAGE(PG8_SA(0, 0), cA, voffA); PG8_STAGE(PG8_SB(0, 1), cB + hstep, voffB); PG8_STAGE(PG8_SA(0, 1), cA + hstep, voffA);
        if (wr == 1) PG8_BAR;
        PG8_WAIT_V(4); PG8_BAR;
        PG8_STAGE(PG8_SB(1, 0), cB + kstep, voffB); PG8_STAGE(PG8_SA(1, 0), cA + kstep, voffA); PG8_STAGE(PG8_SB(1, 1), cB + hstep + kstep, voffB);
        PG8_WAIT_V(6); PG8_BAR;
    }
    for (;;) {
        const bool has_next = S.next(ui + 1, nxt);
        const char* nA = has_next ? (const char*)g.A + (size_t)nxt.pm * tstep : cA; const char* nB = has_next ? (const char*)g.Bt + (size_t)nxt.pn * tstep : cB;
        for (int t = 0; t < nt; t += 2) {
            const bool last = (t == nt - 2);
            const char* a1 = cA + (size_t)(t + 1) * kstep;
            const char* a2 = last ? nA : cA + (size_t)(t + 2) * kstep; const char* b2 = last ? nB : cB + (size_t)(t + 2) * kstep;
            const char* a3 = a2 + kstep; const char* b3 = b2 + kstep;
            if (last && has_next) S.a_ready(nxt);
            if constexpr (SP2) {
            PG8_LDB(B0, 0, 0); PG8_LDB(B1, 0, 1); PG8_SCHED; PG8_LDA(At, 0, 0); PG8_STAGE(PG8_SA(1, 1), a1 + hstep, voffA);
            PG8_WAIT_V(8); PG8_WAIT_L(0); PG8_BAR; PG8_MMA(0, 0, At, B0); PG8_MMA(0, 1, At, B1); PG8_BAR; PG8_SCHED;
            PG8_LDA(At, 0, 1); PG8_STAGE(PG8_SB(0, 0), b2, voffB); PG8_STAGE(PG8_SB(0, 1), b2 + hstep, voffB); PG8_STAGE(PG8_SA(0, 0), a2, voffA);
            PG8_WAIT_V(8); PG8_WAIT_L(0); PG8_BAR; PG8_MMA(1, 0, At, B0); PG8_MMA(1, 1, At, B1); PG8_BAR; PG8_SCHED;
            PG8_LDB(B0, 1, 0); PG8_LDB(B1, 1, 1); PG8_SCHED; PG8_LDA(At, 1, 0); PG8_STAGE(PG8_SA(0, 1), a2 + hstep, voffA);
            PG8_WAIT_V(8); PG8_WAIT_L(0); PG8_BAR; PG8_MMA(0, 0, At, B0); PG8_MMA(0, 1, At, B1); PG8_BAR; PG8_SCHED;
            PG8_LDA(At, 1, 1); PG8_STAGE(PG8_SB(1, 0), b3, voffB); PG8_STAGE(PG8_SB(1, 1), b3 + hstep, voffB); PG8_STAGE(PG8_SA(1, 0), a3, voffA);
            PG8_WAIT_V(8); PG8_WAIT_L(0); PG8_BAR; PG8_MMA(1, 0, At, B0); PG8_MMA(1, 1, At, B1); PG8_BAR; PG8_SCHED;
            } else {
            PG8_LDB(B0, 0, 0); PG8_SCHED; PG8_LDA(At, 0, 0); PG8_STAGE(PG8_SA(1, 1), a1 + hstep, voffA);
            PG8_WAIT_L(8); PG8_BAR; PG8_WAIT_L(0); PG8_MMA(0, 0, At, B0); PG8_BAR; PG8_SCHED;
            PG8_LDB(B1, 0, 1); PG8_STAGE(PG8_SB(0, 0), b2, voffB);
            PG8_BAR; PG8_WAIT_L(0); PG8_MMA(0, 1, At, B1); PG8_BAR;
            PG8_LDA(At, 0, 1); PG8_STAGE(PG8_SA(0, 0), a2, voffA);
            PG8_BAR; PG8_WAIT_L(0); PG8_MMA(1, 0, At, B0); PG8_BAR; PG8_SCHED;
            PG8_STAGE(PG8_SB(0, 1), b2 + hstep, voffB);
            PG8_WAIT_V(6); PG8_BAR; PG8_MMA(1, 1, At, B1); PG8_BAR;
            PG8_LDB(B0, 1, 0); PG8_SCHED; PG8_LDA(At, 1, 0); PG8_STAGE(PG8_SA(0, 1), a2 + hstep, voffA);
            PG8_WAIT_L(8); PG8_BAR; PG8_WAIT_L(0); PG8_MMA(0, 0, At, B0); PG8_BAR; PG8_SCHED;
            PG8_LDB(B1, 1, 1); PG8_STAGE(PG8_SB(1, 0), b3, voffB);
            PG8_BAR; PG8_WAIT_L(0); PG8_MMA(0, 1, At, B1); PG8_BAR;
            PG8_LDA(At, 1, 1); PG8_STAGE(PG8_SA(1, 0), a3, voffA);
            PG8_BAR; PG8_WAIT_L(0); PG8_MMA(1, 0, At, B0); PG8_BAR; PG8_SCHED;
            PG8_STAGE(PG8_SB(1, 1), b3 + hstep, voffB);
            PG8_WAIT_V(6); PG8_BAR; PG8_MMA(1, 1, At, B1); PG8_BAR;
            }
        }
        if constexpr (ALIGN_EPI) { if (wr == 0) PG8_BAR; }
        if constexpr (!Epi::AFTER_DRAIN) { E(acc, cur, wr, wc, fr, fq); S.done(cur); }
        if (!has_next) break;
#pragma unroll
        for (int a = 0; a < 2; ++a)
#pragma unroll
            for (int b = 0; b < 2; ++b)
#pragma unroll
                for (int m = 0; m < 4; ++m)
#pragma unroll
                    for (int n = 0; n < 2; ++n) acc[a][b][m][n] = (f32x4){0.f, 0.f, 0.f, 0.f};
        cur = nxt; cA = nA; cB = nB; ++ui;
        if constexpr (ALIGN_EPI) { if (wr == 1) PG8_BAR; }
    }
    PG8_WAIT_V(0);
    if constexpr (!ALIGN_EPI) { if (wr == 0) PG8_BAR; }
    PG8_BAR;
    if constexpr (Epi::AFTER_DRAIN) { E.fused(acc, cur, wr, wc, fr, fq, lds, wid, lane); S.done(cur); }
#undef PG8_SA
#undef PG8_SB
#undef PG8_STAGE
#undef PG8_LDA
#undef PG8_LDB
#undef PG8_MMA
#undef PG8_WAIT_V
#undef PG8_WAIT_L
#undef PG8_BAR
#undef PG8_SCHED
}
}

#ifndef MK_N_LAUNCHES
#define MK_N_LAUNCHES 1
#endif
constexpr int DM = 2048, SEQ = 4096, MTOK = 8192, INW = 8704;
constexpr int C_Q = 0, C_K = 1024, C_V = 1280, C_AG = 1536, C_U = 2560, C_Z = 3584, C_GA = 4608, C_GS = 6656;
constexpr float LOG2E = 1.4426950408889634f;
constexpr size_t MiB = 1u << 20;
constexpr size_t WS_WIN = 0, WS_WATTN = 34 * MiB, WS_WGLU = 38 * MiB, WS_WSSM = 42 * MiB, WS_WOUT = 46 * MiB;
constexpr size_t WS_H = 54 * MiB, WS_ATTNG = 54 * MiB, WS_YG = 70 * MiB, WS_P = 86 * MiB, WS_MG = 0, WS_BAR = 222 * MiB, WS_BAR_BYTES = 16384, WS_END = 223 * MiB;
constexpr int LDS_CTL = 131072;
constexpr size_t OUT_T = 0, OUT_E = 16 * MiB;
constexpr int LDS_BYTES = 147456;

#define LAS __attribute__((address_space(3)))
typedef unsigned short bf16_t;
typedef unsigned u32x4 __attribute__((ext_vector_type(4)));
typedef unsigned u32x2 __attribute__((ext_vector_type(2)));
typedef float f32x4 __attribute__((ext_vector_type(4)));
typedef short bf16x8 __attribute__((ext_vector_type(8)));

__device__ __forceinline__ unsigned f2bf(float f) { unsigned u = __builtin_bit_cast(unsigned, f); return (u + 0x7fffu + ((u >> 16) & 1u)) >> 16; }
__device__ __forceinline__ float bf2f(unsigned b) { return __builtin_bit_cast(float, b << 16); }
__device__ __forceinline__ float bflo(unsigned w) { return __builtin_bit_cast(float, w << 16); }
__device__ __forceinline__ float bfhi(unsigned w) { return __builtin_bit_cast(float, w & 0xffff0000u); }
__device__ __forceinline__ unsigned pk2(float lo, float hi) { return pg8::cvt_pk_bf16(lo, hi); }
__device__ __forceinline__ float fsigmoid(float x) { return __builtin_amdgcn_rcpf(1.f + __expf(-x)); }
__device__ __forceinline__ float fsilu(float x) { return x * fsigmoid(x); }
__device__ __forceinline__ float fgelu_tanh(float x) { const float z = 0.7978845608028654f * (x + 0.044715f * x * x * x); return x * fsigmoid(2.f * z); }

namespace pg8 {
struct EpiProj {
    static constexpr bool PERM = true, AFTER_DRAIN = false;
    bf16_t* O;
    __device__ __forceinline__ void operator()(const f32x4 (&acc)[2][2][4][2], const Unit& u, int wr, int wc, int fr, int fq) const {
        const int pn = u.pn;
        const int act = (pn >= 18) ? 2 : (((pn >= 6 && pn < 10) || (pn >= 14 && pn < 18)) ? 1 : 0);
        const int row0 = u.pm * BM + wr * 64 + fr, col0 = pn * BM + wc * 32 + 8 * fq;
#pragma unroll
        for (int ai = 0; ai < 2; ++ai)
#pragma unroll
            for (int m = 0; m < 4; ++m) { bf16_t* rowp = O + (size_t)(row0 + ai * HALF + m * 16) * INW + col0;
#pragma unroll
                for (int bj = 0; bj < 2; ++bj) { f32x4 v0 = acc[ai][bj][m][0], v1 = acc[ai][bj][m][1];
                    if (act == 1) {
#pragma unroll
                        for (int i = 0; i < 4; ++i) { v0[i] = fsilu(v0[i]); v1[i] = fsilu(v1[i]); } }
                    else if (act == 2) {
#pragma unroll
                        for (int i = 0; i < 4; ++i) { v0[i] = fsigmoid(v0[i]); v1[i] = fsigmoid(v1[i]); } }
                    u32x4 w; w.x = cvt_pk_bf16(v0[0], v0[1]); w.y = cvt_pk_bf16(v0[2], v0[3]); w.z = cvt_pk_bf16(v1[0], v1[1]); w.w = cvt_pk_bf16(v1[2], v1[3]);
                    *(u32x4*)(rowp + bj * HALF) = w; } }
    }
};
struct EpiYa {
    static constexpr bool PERM = true, AFTER_DRAIN = false;
    const bf16_t* P; bf16_t* Mg;
    __device__ __forceinline__ void operator()(const f32x4 (&acc)[2][2][4][2], const Unit& u, int wr, int wc, int fr, int fq) const {
        const int row0 = u.pm * BM + wr * 64 + fr, col0 = u.pn * BM + wc * 32 + 8 * fq;
#pragma unroll
        for (int ai = 0; ai < 2; ++ai)
#pragma unroll
            for (int m = 0; m < 4; ++m) { const size_t r = (size_t)(row0 + ai * HALF + m * 16);
#pragma unroll
                for (int bj = 0; bj < 2; ++bj) { const f32x4 v0 = acc[ai][bj][m][0], v1 = acc[ai][bj][m][1];
                    const u32x4 g = *(const u32x4*)(P + r * INW + C_GA + col0 + bj * HALF);
                    u32x4 w; w.x = cvt_pk_bf16(v0[0] * bflo(g.x), v0[1] * bfhi(g.x)); w.y = cvt_pk_bf16(v0[2] * bflo(g.y), v0[3] * bfhi(g.y));
                    w.z = cvt_pk_bf16(v1[0] * bflo(g.z), v1[1] * bfhi(g.z)); w.w = cvt_pk_bf16(v1[2] * bflo(g.w), v1[3] * bfhi(g.w));
                    *(u32x4*)(Mg + r * DM + col0 + bj * HALF) = w; } }
    }
};
struct EpiGlu {
    static constexpr bool PERM = true, AFTER_DRAIN = false;
    const bf16_t* P; bf16_t* T; const float* bias;
    __device__ __forceinline__ void operator()(const f32x4 (&acc)[2][2][4][2], const Unit& u, int wr, int wc, int fr, int fq) const {
        const int row0 = u.pm * BM + wr * 64 + fr, col0 = u.pn * HALF + wc * 32 + 8 * fq;
        const f32x4 ba0 = *(const f32x4*)(bias + col0), ba1 = *(const f32x4*)(bias + col0 + 4);
        const f32x4 bb0 = *(const f32x4*)(bias + 1024 + col0), bb1 = *(const f32x4*)(bias + 1024 + col0 + 4);
#pragma unroll
        for (int ai = 0; ai < 2; ++ai)
#pragma unroll
            for (int m = 0; m < 4; ++m) { const size_t r = (size_t)(row0 + ai * HALF + m * 16);
                const f32x4 a0 = acc[ai][0][m][0] + ba0, a1 = acc[ai][0][m][1] + ba1, b0 = acc[ai][1][m][0] + bb0, b1 = acc[ai][1][m][1] + bb1;
                const u32x4 z = *(const u32x4*)(P + r * INW + C_Z + col0);
                u32x4 w;
                w.x = cvt_pk_bf16(a0[0] * fsigmoid(b0[0]) * bflo(z.x), a0[1] * fsigmoid(b0[1]) * bfhi(z.x));
                w.y = cvt_pk_bf16(a0[2] * fsigmoid(b0[2]) * bflo(z.y), a0[3] * fsigmoid(b0[3]) * bfhi(z.y));
                w.z = cvt_pk_bf16(a1[0] * fsigmoid(b1[0]) * bflo(z.z), a1[1] * fsigmoid(b1[1]) * bfhi(z.z));
                w.w = cvt_pk_bf16(a1[2] * fsigmoid(b1[2]) * bflo(z.w), a1[3] * fsigmoid(b1[3]) * bfhi(z.w));
                *(u32x4*)(T + r * 1024 + col0) = w; }
    }
};
struct EpiYs {
    static constexpr bool PERM = true, AFTER_DRAIN = false;
    const bf16_t* P; bf16_t* Mg;
    __device__ __forceinline__ void operator()(const f32x4 (&acc)[2][2][4][2], const Unit& u, int wr, int wc, int fr, int fq) const {
        const int row0 = u.pm * BM + wr * 64 + fr, col0 = u.pn * BM + wc * 32 + 8 * fq;
#pragma unroll
        for (int ai = 0; ai < 2; ++ai)
#pragma unroll
            for (int m = 0; m < 4; ++m) { const size_t r = (size_t)(row0 + ai * HALF + m * 16);
#pragma unroll
                for (int bj = 0; bj < 2; ++bj) { const f32x4 v0 = acc[ai][bj][m][0], v1 = acc[ai][bj][m][1];
                    const u32x4 g = *(const u32x4*)(P + r * INW + C_GS + col0 + bj * HALF);
                    const u32x4 p = *(const u32x4*)(Mg + r * DM + col0 + bj * HALF);
                    u32x4 w; w.x = cvt_pk_bf16(bflo(p.x) + v0[0] * bflo(g.x), bfhi(p.x) + v0[1] * bfhi(g.x)); w.y = cvt_pk_bf16(bflo(p.y) + v0[2] * bflo(g.y), bfhi(p.y) + v0[3] * bfhi(g.y));
                    w.z = cvt_pk_bf16(bflo(p.z) + v1[0] * bflo(g.z), bfhi(p.z) + v1[1] * bfhi(g.z)); w.w = cvt_pk_bf16(bflo(p.w) + v1[2] * bflo(g.w), bfhi(p.w) + v1[3] * bfhi(g.w));
                    *(u32x4*)(Mg + r * DM + col0 + bj * HALF) = w; } }
    }
};
struct EpiOut {
    static constexpr bool PERM = true, AFTER_DRAIN = false;
    const float* X; float* O;
    __device__ __forceinline__ void operator()(const f32x4 (&acc)[2][2][4][2], const Unit& u, int wr, int wc, int fr, int fq) const {
        const int row0 = u.pm * BM + wr * 64 + fr, col0 = u.pn * BM + wc * 32 + 8 * fq;
#pragma unroll
        for (int ai = 0; ai < 2; ++ai)
#pragma unroll
            for (int m = 0; m < 4; ++m) { const size_t off = (size_t)(row0 + ai * HALF + m * 16) * DM + col0;
#pragma unroll
                for (int bj = 0; bj < 2; ++bj) {
                    const f32x4 x0 = *(const f32x4*)(X + off + bj * HALF), x1 = *(const f32x4*)(X + off + bj * HALF + 4);
                    *(f32x4*)(O + off + bj * HALF) = x0 + acc[ai][bj][m][0]; *(f32x4*)(O + off + bj * HALF + 4) = x1 + acc[ai][bj][m][1]; } }
    }
};
}

__device__ __forceinline__ float wave_sum(float v) {
#pragma unroll
    for (int o = 1; o < 64; o <<= 1) v += __shfl_xor(v, o);
    return v;
}
__device__ __forceinline__ void p0_transpose_item(const float* W, int K, int N, bf16_t* WT, bool glu, LAS float* scr, int item, int lane) {
    const int nblk = N / 32, kb = item / nblk, nb = item % nblk, k0 = 64 * kb, n0 = 32 * nb;
#pragma unroll 8
    for (int i = 0; i < 32; ++i) { const int kk = 2 * i + (lane >> 5); scr[kk * 33 + (lane & 31)] = W[(size_t)(k0 + kk) * N + n0 + (lane & 31)]; }
    asm volatile("s_waitcnt lgkmcnt(0)" ::: "memory");
    int d0 = n0;
    if (glu) d0 = (n0 < 1024) ? (256 * (n0 >> 7) + (n0 & 127)) : (256 * ((n0 - 1024) >> 7) + 128 + (n0 & 127));
    const int c = lane & 7;
#pragma unroll
    for (int j = 0; j < 4; ++j) { const int n = (lane >> 3) + 8 * j; const LAS float* s = scr + (8 * c) * 33 + n;
        u32x4 o; o.x = pk2(s[0 * 33], s[1 * 33]); o.y = pk2(s[2 * 33], s[3 * 33]); o.z = pk2(s[4 * 33], s[5 * 33]); o.w = pk2(s[6 * 33], s[7 * 33]);
        *(u32x4*)(WT + (size_t)(d0 + n) * K + k0 + 8 * c) = o; }
    asm volatile("s_waitcnt lgkmcnt(0)" ::: "memory");
}

struct Args { const float* in[19]; float* out; unsigned char* ws; int ph_lo, ph_hi; };

__device__ __forceinline__ void p0_prologue(const Args& a, LAS unsigned char* lds, int wave, int lane) {
    LAS float* scr = (LAS float*)(lds + wave * 16384);
    const int gw = blockIdx.x * 8 + wave, NGW = gridDim.x * 8;
    constexpr int I_IN = (DM / 64) * (INW / 32), I_A = (1024 / 64) * (2048 / 32), I_O = (2048 / 64) * (2048 / 32);
    constexpr int NITEMS = I_IN + 3 * I_A + I_O;
    unsigned char* ws = a.ws;
    for (int it = gw; it < NITEMS; it += NGW) {
        int r = it;
        if (r < I_IN) { p0_transpose_item(a.in[2], DM, INW, (bf16_t*)(ws + WS_WIN), false, scr, r, lane); continue; } r -= I_IN;
        if (r < I_A) { p0_transpose_item(a.in[6], 1024, 2048, (bf16_t*)(ws + WS_WATTN), false, scr, r, lane); continue; } r -= I_A;
        if (r < I_A) { p0_transpose_item(a.in[15], 1024, 2048, (bf16_t*)(ws + WS_WGLU), true, scr, r, lane); continue; } r -= I_A;
        if (r < I_A) { p0_transpose_item(a.in[17], 1024, 2048, (bf16_t*)(ws + WS_WSSM), false, scr, r, lane); continue; } r -= I_A;
        p0_transpose_item(a.in[18], 2048, 2048, (bf16_t*)(ws + WS_WOUT), false, scr, r, lane);
    }
    const float* x = a.in[0]; const float* nw = a.in[1]; bf16_t* H = (bf16_t*)(ws + WS_H);
    f32x4 wv[8];
#pragma unroll
    for (int j = 0; j < 8; ++j) wv[j] = *((const f32x4*)nw + lane + 64 * j);
    for (int m = gw; m < MTOK; m += NGW) {
        const f32x4* xr = (const f32x4*)(x + (size_t)m * DM) + lane;
        f32x4 v[8]; float s = 0.f;
#pragma unroll
        for (int j = 0; j < 8; ++j) { v[j] = xr[64 * j]; s += (v[j].x * v[j].x + v[j].y * v[j].y) + (v[j].z * v[j].z + v[j].w * v[j].w); }
        const float rstd = rsqrtf(wave_sum(s) * (1.f / DM) + 1e-6f);
        u32x2* o8 = (u32x2*)(H + (size_t)m * DM) + lane;
#pragma unroll
        for (int j = 0; j < 8; ++j) { u32x2 o; o.x = pk2(v[j].x * rstd * wv[j].x, v[j].y * rstd * wv[j].y); o.y = pk2(v[j].z * rstd * wv[j].z, v[j].w * rstd * wv[j].w); o8[64 * j] = o; }
    }
}

constexpr int KL_STRIDE = 144, VT_STRIDE = 528, KL_BYTES = 256 * KL_STRIDE;
__device__ __forceinline__ void attn_unit(LAS unsigned char* lds, const bf16_t* P, bf16_t* AttnG, const float* qw, const float* kw, const float* sinks, int b, int blk, int g, int tid) {
    const int lane = tid & 63, w = tid >> 6, fr = lane & 15, fq = lane >> 4;
    const long base = (long)b * SEQ + (long)blk * 128;
    LAS unsigned char* Kl = lds; LAS unsigned char* Vt = lds + KL_BYTES;
    const long tok = base + 16 * w + fr;
    u32x4 qraw[4][2]; u32x2 graw[4][4];
#pragma unroll
    for (int r = 0; r < 4; ++r) { const int h = 4 * g + r;
        qraw[r][0] = *(const u32x4*)(P + (size_t)tok * INW + C_Q + h * 64 + 8 * fq); qraw[r][1] = *(const u32x4*)(P + (size_t)tok * INW + C_Q + h * 64 + 32 + 8 * fq);
#pragma unroll
        for (int dt = 0; dt < 4; ++dt) graw[r][dt] = *(const u32x2*)(P + (size_t)tok * INW + C_AG + h * 64 + 16 * dt + 4 * fq); }
    {
        const int c = tid & 7;
        const f32x4 kw0 = *(const f32x4*)(kw + 8 * c), kw1 = *(const f32x4*)(kw + 8 * c + 4);
#pragma unroll
        for (int i = 0; i < 4; ++i) { const int key = (tid >> 3) + 64 * i; const long row = base - 128 + key;
            u32x4 raw = (u32x4){0u, 0u, 0u, 0u};
            if (blk > 0 || key >= 128) raw = *(const u32x4*)(P + (size_t)row * INW + C_K + g * 64 + 8 * c);
            float f[8] = {bflo(raw.x), bfhi(raw.x), bflo(raw.y), bfhi(raw.y), bflo(raw.z), bfhi(raw.z), bflo(raw.w), bfhi(raw.w)};
            float ss = 0.f;
#pragma unroll
            for (int e = 0; e < 8; ++e) ss += f[e] * f[e];
            ss += __shfl_xor(ss, 1); ss += __shfl_xor(ss, 2); ss += __shfl_xor(ss, 4);
            const float rstd = rsqrtf(ss * (1.f / 64.f) + 1e-6f);
            u32x4 o; o.x = pk2(f[0] * rstd * kw0[0], f[1] * rstd * kw0[1]); o.y = pk2(f[2] * rstd * kw0[2], f[3] * rstd * kw0[3]);
            o.z = pk2(f[4] * rstd * kw1[0], f[5] * rstd * kw1[1]); o.w = pk2(f[6] * rstd * kw1[2], f[7] * rstd * kw1[3]);
            *(LAS u32x4*)(Kl + key * KL_STRIDE + c * 16) = o; }
    }
    {
#pragma unroll
        for (int i = 0; i < 4; ++i) { const int key = lane + 64 * i; const long row = base - 128 + key;
            u32x4 raw = (u32x4){0u, 0u, 0u, 0u};
            if (blk > 0 || key >= 128) raw = *(const u32x4*)(P + (size_t)row * INW + C_V + g * 64 + 8 * w);
            LAS unsigned short* vp = (LAS unsigned short*)(Vt + (8 * w) * VT_STRIDE + key * 2);
            vp[0 * (VT_STRIDE / 2)] = (unsigned short)(raw.x & 0xffffu); vp[1 * (VT_STRIDE / 2)] = (unsigned short)(raw.x >> 16);
            vp[2 * (VT_STRIDE / 2)] = (unsigned short)(raw.y & 0xffffu); vp[3 * (VT_STRIDE / 2)] = (unsigned short)(raw.y >> 16);
            vp[4 * (VT_STRIDE / 2)] = (unsigned short)(raw.z & 0xffffu); vp[5 * (VT_STRIDE / 2)] = (unsigned short)(raw.z >> 16);
            vp[6 * (VT_STRIDE / 2)] = (unsigned short)(raw.w & 0xffffu); vp[7 * (VT_STRIDE / 2)] = (unsigned short)(raw.w >> 16); }
    }
    __syncthreads();
    const f32x4 qwa0 = *(const f32x4*)(qw + 8 * fq), qwa1 = *(const f32x4*)(qw + 8 * fq + 4), qwb0 = *(const f32x4*)(qw + 32 + 8 * fq), qwb1 = *(const f32x4*)(qw + 32 + 8 * fq + 4);
#pragma unroll
    for (int r = 0; r < 4; ++r) {
        const int h = 4 * g + r;
        const u32x4 r0 = qraw[r][0], r1 = qraw[r][1];
        float q0[8] = {bflo(r0.x), bfhi(r0.x), bflo(r0.y), bfhi(r0.y), bflo(r0.z), bfhi(r0.z), bflo(r0.w), bfhi(r0.w)};
        float q1[8] = {bflo(r1.x), bfhi(r1.x), bflo(r1.y), bfhi(r1.y), bflo(r1.z), bfhi(r1.z), bflo(r1.w), bfhi(r1.w)};
        float ss = 0.f;
#pragma unroll
        for (int e = 0; e < 8; ++e) ss += q0[e] * q0[e] + q1[e] * q1[e];
        ss += __shfl_xor(ss, 16); ss += __shfl_xor(ss, 32);
        const float qs = rsqrtf(ss * (1.f / 64.f) + 1e-6f) * (0.125f * LOG2E);
        u32x4 qa, qb;
        qa.x = pk2(q0[0] * qs * qwa0[0], q0[1] * qs * qwa0[1]); qa.y = pk2(q0[2] * qs * qwa0[2], q0[3] * qs * qwa0[3]); qa.z = pk2(q0[4] * qs * qwa1[0], q0[5] * qs * qwa1[1]); qa.w = pk2(q0[6] * qs * qwa1[2], q0[7] * qs * qwa1[3]);
        qb.x = pk2(q1[0] * qs * qwb0[0], q1[1] * qs * qwb0[1]); qb.y = pk2(q1[2] * qs * qwb0[2], q1[3] * qs * qwb0[3]); qb.z = pk2(q1[4] * qs * qwb1[0], q1[5] * qs * qwb1[1]); qb.w = pk2(q1[6] * qs * qwb1[2], q1[7] * qs * qwb1[3]);
        const bf16x8 qf0 = __builtin_bit_cast(bf16x8, qa), qf1 = __builtin_bit_cast(bf16x8, qb);
        f32x4 s[9];
#pragma unroll
        for (int tt = 0; tt < 9; ++tt) { const LAS unsigned char* kp = Kl + (16 * (w + tt) + fr) * KL_STRIDE + 16 * fq;
            const bf16x8 a0 = *(const LAS bf16x8*)kp, a1 = *(const LAS bf16x8*)(kp + 64);
            f32x4 z = (f32x4){0.f, 0.f, 0.f, 0.f};
            z = __builtin_amdgcn_mfma_f32_16x16x32_bf16(a0, qf0, z, 0, 0, 0); s[tt] = __builtin_amdgcn_mfma_f32_16x16x32_bf16(a1, qf1, z, 0, 0, 0); }
        const float sink2 = sinks[h] * LOG2E; float mx = sink2;
#pragma unroll
        for (int tt = 0; tt < 9; ++tt)
#pragma unroll
            for (int j = 0; j < 4; ++j) { const int diff = 128 + fr - 16 * tt - 4 * fq - j; const bool ok = (diff >= 0) && (diff < 128) && (blk > 0 || (w + tt) >= 8);
                s[tt][j] = ok ? s[tt][j] : -INFINITY; mx = fmaxf(mx, s[tt][j]); }
        mx = fmaxf(mx, __shfl_xor(mx, 16)); mx = fmaxf(mx, __shfl_xor(mx, 32));
        float l = 0.f;
#pragma unroll
        for (int tt = 0; tt < 9; ++tt)
#pragma unroll
            for (int j = 0; j < 4; ++j) { s[tt][j] = __builtin_amdgcn_exp2f(s[tt][j] - mx); l += s[tt][j]; }
        l += __shfl_xor(l, 16); l += __shfl_xor(l, 32); l += __builtin_amdgcn_exp2f(sink2 - mx);
        const float inv = 1.f / l;
        f32x4 o[4];
#pragma unroll
        for (int dt = 0; dt < 4; ++dt) o[dt] = (f32x4){0.f, 0.f, 0.f, 0.f};
#pragma unroll
        for (int cc = 0; cc < 5; ++cc) { const int T1 = w + 2 * cc; const int T2c = (T1 + 1 > 15) ? 15 : (T1 + 1);
            u32x4 pw; pw.x = pk2(s[2 * cc][0], s[2 * cc][1]); pw.y = pk2(s[2 * cc][2], s[2 * cc][3]);
            if (cc < 4) { pw.z = pk2(s[2 * cc + 1 > 8 ? 8 : 2 * cc + 1][0], s[2 * cc + 1 > 8 ? 8 : 2 * cc + 1][1]); pw.w = pk2(s[2 * cc + 1 > 8 ? 8 : 2 * cc + 1][2], s[2 * cc + 1 > 8 ? 8 : 2 * cc + 1][3]); } else { pw.z = 0u; pw.w = 0u; }
            const bf16x8 pf = __builtin_bit_cast(bf16x8, pw);
#pragma unroll
            for (int dt = 0; dt < 4; ++dt) { const LAS unsigned char* vp = Vt + (16 * dt + fr) * VT_STRIDE;
                const u32x2 lo = *(const LAS u32x2*)(vp + (16 * T1 + 4 * fq) * 2), hi = *(const LAS u32x2*)(vp + (16 * T2c + 4 * fq) * 2);
                u32x4 av; av.x = lo.x; av.y = lo.y; av.z = hi.x; av.w = hi.y;
                o[dt] = __builtin_amdgcn_mfma_f32_16x16x32_bf16(__builtin_bit_cast(bf16x8, av), pf, o[dt], 0, 0, 0); } }
#pragma unroll
        for (int dt = 0; dt < 4; ++dt) { const int col = h * 64 + 16 * dt + 4 * fq;
            const u32x2 gt = graw[r][dt];
            u32x2 ov; ov.x = pk2(o[dt][0] * inv * bflo(gt.x), o[dt][1] * inv * bfhi(gt.x)); ov.y = pk2(o[dt][2] * inv * bflo(gt.y), o[dt][3] * inv * bfhi(gt.y));
            *(u32x2*)(AttnG + (size_t)tok * 1024 + col) = ov; }
    }
    __syncthreads();
}

constexpr int SW_RS = 132, SW_BYTES = 16 * SW_RS * 4;
constexpr int SSM_CH = 256, SSM_NCH = SEQ / SSM_CH, SSM_NST = SSM_CH / 16, SSM_ITEMS = 2 * 64 * SSM_NCH;
typedef float f32x2 __attribute__((ext_vector_type(2)));
template <bool PASSB>
__device__ __forceinline__ void ssm_item(LAS unsigned char* wl, const Args& a, const bf16_t* P, float* E, bf16_t* Yg, int b, int g, int c, int lane) {
    const int fr = lane & 15, fq = lane >> 4;
    const float* A_re = a.in[7]; const float* A_im = a.in[8]; const float* log_dt = a.in[9]; const float* B_re = a.in[10]; const float* B_im = a.in[11];
    const float* C_re = a.in[12]; const float* C_im = a.in[13]; const float* D_skip = a.in[14];
    const float dt = expf(log_dt[g]);
    float abr, abi;
    { const float ar = A_re[g * 64 + lane], ai = A_im[g * 64 + lane]; const float mag = expf(dt * ar); float sn, cs; sincosf(dt * ai, &sn, &cs); abr = mag * cs; abi = mag * sn; }
    bf16x8 bq[8];
#pragma unroll
    for (int nt = 0; nt < 8; ++nt) { const int p = 8 * nt + (fr >> 1);
        const float ar = A_re[g * 64 + p], ai = A_im[g * 64 + p]; const float mag = expf(dt * ar); float sn, cs; sincosf(dt * ai, &sn, &cs);
        const float nr = mag * cs - 1.0f, ni = mag * sn, den = ar * ar + ai * ai; const float cfr = (nr * ar + ni * ai) / den, cfi = (ni * ar - nr * ai) / den;
        const float* br = B_re + ((size_t)(g * 64 + p)) * 16 + 8 * (fq & 1); const float* bi = B_im + ((size_t)(g * 64 + p)) * 16 + 8 * (fq & 1);
        const f32x4 br0 = *(const f32x4*)br, br1 = *(const f32x4*)(br + 4), bi0 = *(const f32x4*)bi, bi1 = *(const f32x4*)(bi + 4);
        const float m0 = (fr & 1) ? cfi : cfr, m1 = (fr & 1) ? cfr : -cfi;
        float v[8];
#pragma unroll
        for (int i = 0; i < 4; ++i) { v[i] = m0 * br0[i] + m1 * bi0[i]; v[4 + i] = m0 * br1[i] + m1 * bi1[i]; }
        if (fq >= 2) {
#pragma unroll
            for (int i = 0; i < 8; ++i) v[i] = v[i] - bf2f(f2bf(v[i])); }
        u32x4 w_; w_.x = pk2(v[0], v[1]); w_.y = pk2(v[2], v[3]); w_.z = pk2(v[4], v[5]); w_.w = pk2(v[6], v[7]);
        bq[nt] = __builtin_bit_cast(bf16x8, w_); }
    bf16x8 cch[4], ccl[4]; float dsk[4];
    if (PASSB) {
#pragma unroll
        for (int ks = 0; ks < 4; ++ks) { const size_t co = ((size_t)(g * 16 + fr)) * 64 + 16 * ks + 4 * fq;
            const f32x4 cr = *(const f32x4*)(C_re + co), ci = *(const f32x4*)(C_im + co);
            float v[8] = {cr[0], -ci[0], cr[1], -ci[1], cr[2], -ci[2], cr[3], -ci[3]}; float lo[8];
#pragma unroll
            for (int i = 0; i < 8; ++i) lo[i] = v[i] - bf2f(f2bf(v[i]));
            u32x4 wh, wl_; wh.x = pk2(v[0], v[1]); wh.y = pk2(v[2], v[3]); wh.z = pk2(v[4], v[5]); wh.w = pk2(v[6], v[7]);
            wl_.x = pk2(lo[0], lo[1]); wl_.y = pk2(lo[2], lo[3]); wl_.z = pk2(lo[4], lo[5]); wl_.w = pk2(lo[6], lo[7]);
            cch[ks] = __builtin_bit_cast(bf16x8, wh); ccl[ks] = __builtin_bit_cast(bf16x8, wl_); }
#pragma unroll
        for (int j = 0; j < 4; ++j) dsk[j] = D_skip[g * 16 + 4 * fq + j];
    }
    const long tok0 = (long)b * SEQ + (long)c * SSM_CH;
    const bf16_t* up = P + (size_t)(tok0 + fr) * INW + C_U + 16 * g;
    float sr = 0.f, si = 0.f;
    if (PASSB) {
        const float* Eb = E + ((size_t)(b * 64 + g) * SSM_NCH) * 128;
        float pr = abr, pi = abi;
#pragma unroll
        for (int i = 0; i < 8; ++i) { const float nr = pr * pr - pi * pi, ni = 2.f * pr * pi; pr = nr; pi = ni; }
        for (int cp = 0; cp < c; ++cp) { const float er = Eb[(size_t)cp * 128 + lane], ei = Eb[(size_t)cp * 128 + 64 + lane];
            const float nr = fmaf(pr, sr, fmaf(-pi, si, er)), ni = fmaf(pr, si, fmaf(pi, sr, ei)); sr = nr; si = ni; }
    }
    LAS float* W = (LAS float*)wl; LAS unsigned* Wu = (LAS unsigned*)wl;
    u32x4 ucur = *(const u32x4*)(up + 8 * (fq & 1));
    u32x2 uucur = (u32x2){0u, 0u};
    if (PASSB) uucur = *(const u32x2*)(up + 4 * fq);
#pragma unroll 1
    for (int st = 0; st < SSM_NST; ++st) {
        const int stn = (st + 1 < SSM_NST) ? st + 1 : st;
        const u32x4 unext = *(const u32x4*)(up + (size_t)stn * 16 * INW + 8 * (fq & 1));
        u32x2 uunext = (u32x2){0u, 0u};
        if (PASSB) uunext = *(const u32x2*)(up + (size_t)stn * 16 * INW + 4 * fq);
        const bf16x8 uf = __builtin_bit_cast(bf16x8, ucur);
#pragma unroll
        for (int nt = 0; nt < 8; ++nt) { f32x4 z = (f32x4){0.f, 0.f, 0.f, 0.f};
            z = __builtin_amdgcn_mfma_f32_16x16x32_bf16(bq[nt], uf, z, 0, 0, 0);
            *(LAS f32x4*)(W + fr * SW_RS + 16 * nt + 4 * fq) = z; }
        asm volatile("s_waitcnt lgkmcnt(0)" ::: "memory");
        f32x2 bb[16];
#pragma unroll
        for (int t = 0; t < 16; ++t) bb[t] = *(const LAS f32x2*)(W + t * SW_RS + 2 * lane);
        asm volatile("s_waitcnt lgkmcnt(0)" ::: "memory");
#pragma unroll
        for (int t = 0; t < 16; ++t) {
            const float nr = fmaf(abr, sr, fmaf(-abi, si, bb[t].x)), ni = fmaf(abr, si, fmaf(abi, sr, bb[t].y)); sr = nr; si = ni;
            if (PASSB) { const unsigned hh = pk2(sr, si); const unsigned ll = pk2(sr - bflo(hh), si - bfhi(hh)); Wu[t * SW_RS + lane] = hh; Wu[t * SW_RS + 64 + lane] = ll; } }
        if (PASSB) {
            asm volatile("s_waitcnt lgkmcnt(0)" ::: "memory");
            f32x4 y = (f32x4){0.f, 0.f, 0.f, 0.f};
#pragma unroll
            for (int ks = 0; ks < 4; ++ks) { const bf16x8 fh = *(const LAS bf16x8*)(Wu + fr * SW_RS + 16 * ks + 4 * fq), fl = *(const LAS bf16x8*)(Wu + fr * SW_RS + 64 + 16 * ks + 4 * fq);
                y = __builtin_amdgcn_mfma_f32_16x16x32_bf16(cch[ks], fh, y, 0, 0, 0);
                y = __builtin_amdgcn_mfma_f32_16x16x32_bf16(cch[ks], fl, y, 0, 0, 0);
                y = __builtin_amdgcn_mfma_f32_16x16x32_bf16(ccl[ks], fh, y, 0, 0, 0); }
            const float y0 = fgelu_tanh(y[0] + dsk[0] * bflo(uucur.x)), y1 = fgelu_tanh(y[1] + dsk[1] * bfhi(uucur.x)), y2 = fgelu_tanh(y[2] + dsk[2] * bflo(uucur.y)), y3 = fgelu_tanh(y[3] + dsk[3] * bfhi(uucur.y));
            u32x2 ov; ov.x = pk2(y0, y1); ov.y = pk2(y2, y3);
            *(u32x2*)(Yg + (size_t)(tok0 + 16 * st + fr) * 1024 + 16 * g + 4 * fq) = ov;
            asm volatile("s_waitcnt lgkmcnt(0)" ::: "memory");
        }
        ucur = unext; uucur = uunext;
    }
    if (!PASSB) { float* Eo = E + ((size_t)((b * 64 + g) * SSM_NCH + c)) * 128; Eo[lane] = sr; Eo[64 + lane] = si; }
}

#define XB_TMO      128
#define XB_XCNT(j)  (256  + 64 * (j))
#define XB_XSUB(j)  (1280 + 64 * (j))
#define XB_XGEN(j)  (2304 + 64 * (j))
#define XB_TOP      3328
#define XB_TOPGEN   3392
#define XCD_BAR_WORDS 3456
#define XB_SPIN_CAP (1u << 18)

__device__ __forceinline__ unsigned xb_ld(unsigned* p)              { return __hip_atomic_load(p, __ATOMIC_RELAXED, __HIP_MEMORY_SCOPE_AGENT); }
__device__ __forceinline__ unsigned xb_add(unsigned* p, unsigned v) { return __hip_atomic_fetch_add(p, v, __ATOMIC_RELAXED, __HIP_MEMORY_SCOPE_AGENT); }
__device__ __forceinline__ unsigned xb_xcc_id() { return (unsigned)__builtin_amdgcn_s_getreg((3 << 11) | 20) & 0xFu; }
#define XB_SPIN(cond, bar) do { unsigned _sp = 0; while (cond) { __builtin_amdgcn_s_sleep(1); \
    if ((++_sp & 255u) == 0u) { if (xb_ld(&(bar)[XB_TMO])) break; if (_sp > XB_SPIN_CAP) { atomicAdd(&(bar)[XB_TMO], 1u); break; } } } } while (0)

struct XcdBarrier {
    unsigned* bar; unsigned x;
    volatile LAS unsigned* st;
};

__device__ __forceinline__ XcdBarrier xcd_barrier_post(unsigned* bar, volatile LAS unsigned* st) {
    XcdBarrier b; b.bar = bar; b.x = xb_xcc_id(); b.st = st;
    if (threadIdx.x == 0) (void)xb_add(&bar[XB_XCNT(b.x)], 1u);
    return b;
}
__device__ __forceinline__ void xcd_barrier_complete(unsigned* bar, unsigned x, unsigned& nloc, unsigned& nx) {
    const unsigned G = gridDim.x * gridDim.y * gridDim.z;
    unsigned sum, cnt, mine, sp = 0u;
    for (;;) {
        sum = 0u; cnt = 0u; mine = 0u;
#pragma unroll
        for (unsigned j = 0; j < 16; ++j) { const unsigned c = xb_ld(&bar[XB_XCNT(j)]); sum += c; cnt += (c > 0u) ? 1u : 0u; mine = (j == x) ? c : mine; }
        if (sum == G) break;
        __builtin_amdgcn_s_sleep(1);
        if ((++sp & 255u) == 0u) { if (xb_ld(&bar[XB_TMO])) break; if (sp > XB_SPIN_CAP) { atomicAdd(&bar[XB_TMO], 1u); break; } }
    }
    nloc = mine > 0u ? mine : 1u; nx = cnt > 0u ? cnt : 1u;
}

__device__ __forceinline__ void xcd_barrier(const XcdBarrier& b) {
    asm volatile("s_waitcnt vmcnt(0)" ::: "memory");
    __syncthreads();
    if (threadIdx.x == 0) {
        unsigned* bar = b.bar;
        __builtin_amdgcn_s_waitcnt(0);
        unsigned nloc = b.st[0], nx = b.st[1];
        if (nloc == 0u) { xcd_barrier_complete(bar, b.x, nloc, nx); b.st[0] = nloc; b.st[1] = nx; }
        const unsigned old = xb_add(&bar[XB_XSUB(b.x)], 1u);
        const unsigned gen = old / nloc;
        if (old + 1u == (gen + 1u) * nloc) {
            __builtin_amdgcn_fence(__ATOMIC_RELEASE, "agent");
            asm volatile("s_waitcnt vmcnt(0)" ::: "memory");
            const unsigned og = xb_add(&bar[XB_TOP], 1u);
            const unsigned tg = og / nx;
            if (og + 1u == (tg + 1u) * nx) xb_add(&bar[XB_TOPGEN], 1u);
            else XB_SPIN(xb_ld(&bar[XB_TOPGEN]) == tg, bar);
            __builtin_amdgcn_fence(__ATOMIC_ACQUIRE, "agent");
            xb_add(&bar[XB_XGEN(b.x)], 1u);
            asm volatile("s_waitcnt vmcnt(0)" ::: "memory");
        } else {
            XB_SPIN(xb_ld(&bar[XB_XGEN(b.x)]) == gen, bar);
            __builtin_amdgcn_fence(__ATOMIC_ACQUIRE, "agent");
            asm volatile("s_waitcnt vmcnt(0)" ::: "memory");
        }
    }
    __syncthreads();
}

__global__ void __launch_bounds__(512, 2) fwd(Args a) {
    extern __shared__ __attribute__((aligned(16))) unsigned char lds_raw[];
    LAS unsigned char* lds = (LAS unsigned char*)lds_raw;
    cg::grid_group grid = cg::this_grid();
    const int tid = threadIdx.x, lane = tid & 63, wave = __builtin_amdgcn_readfirstlane(tid >> 6);
    const int G = gridDim.x, bx = blockIdx.x;
    unsigned char* ws = a.ws;
    bf16_t* WinT = (bf16_t*)(ws + WS_WIN); bf16_t* WattnT = (bf16_t*)(ws + WS_WATTN); bf16_t* WgluT = (bf16_t*)(ws + WS_WGLU); bf16_t* WssmT = (bf16_t*)(ws + WS_WSSM); bf16_t* WoutT = (bf16_t*)(ws + WS_WOUT);
    bf16_t* H = (bf16_t*)(ws + WS_H); bf16_t* AttnG = (bf16_t*)(ws + WS_ATTNG); bf16_t* Yg = (bf16_t*)(ws + WS_YG); bf16_t* P = (bf16_t*)(ws + WS_P); bf16_t* Mg = (bf16_t*)(ws + WS_MG);
    bf16_t* T = (bf16_t*)((unsigned char*)a.out + OUT_T); float* E = (float*)((unsigned char*)a.out + OUT_E);
    const int lo = a.ph_lo, hi = a.ph_hi;
#define IN(k) (lo <= (k) && (k) < hi)
    if (tid < 16) ((LAS unsigned*)(lds + LDS_CTL))[tid] = 0u;
    __syncthreads();
    XcdBarrier bar = xcd_barrier_post((unsigned*)(ws + WS_BAR), (volatile LAS unsigned*)(lds + LDS_CTL) + 8);
    if (hi == 99) grid.sync();
#define SEAM(k) do { if (IN(k) && IN((k) + 1)) xcd_barrier(bar); } while (0)

    if (IN(0)) { p0_prologue(a, lds, wave, lane); __syncthreads(); }
    SEAM(0);
    if (IN(1)) { pg8::Gemm g{H, WinT, MTOK, INW, DM}; pg8::StaticOrder S; S.init(MTOK, INW, G, bx); pg8::EpiProj Ep{P};
        pg8::gemm_phase<pg8::EpiProj, pg8::StaticOrder, true, true>(lds, g, S, Ep); }
    SEAM(1);
    if (IN(2)) {
        for (int u = bx; u < 256; u += G) { const int g = u & 3, blk = (u >> 2) & 31, b = u >> 7; attn_unit(lds, P, AttnG, a.in[3], a.in[4], a.in[5], b, blk, g, tid); }
        const int gw = bx * 8 + wave, NGW = G * 8;
        for (int it = gw; it < SSM_ITEMS; it += NGW) { const int c = it & (SSM_NCH - 1), g = (it / SSM_NCH) & 63, b = it / (SSM_NCH * 64); ssm_item<false>(lds + wave * SW_BYTES, a, P, E, Yg, b, g, c, lane); }
        __syncthreads();
    }
    SEAM(2);
    if (IN(3)) {
        const int gw = bx * 8 + wave, NGW = G * 8;
        for (int it = gw; it < SSM_ITEMS; it += NGW) { const int c = it & (SSM_NCH - 1), g = (it / SSM_NCH) & 63, b = it / (SSM_NCH * 64); ssm_item<true>(lds + wave * SW_BYTES, a, P, E, Yg, b, g, c, lane); }
        __syncthreads();
        pg8::Gemm g{AttnG, WattnT, MTOK, DM, 1024}; pg8::StaticOrder S; S.init(MTOK, DM, G, bx); pg8::EpiYa Ep{P, Mg};
        pg8::gemm_phase<pg8::EpiYa, pg8::StaticOrder, true, true>(lds, g, S, Ep);
    }
    SEAM(3);
    if (IN(4)) { pg8::Gemm g{Yg, WgluT, MTOK, DM, 1024}; pg8::StaticOrder S; S.init(MTOK, DM, G, bx); pg8::EpiGlu Ep{P, T, a.in[16]};
        pg8::gemm_phase<pg8::EpiGlu, pg8::StaticOrder, true, true>(lds, g, S, Ep); }
    SEAM(4);
    if (IN(5)) { pg8::Gemm g{T, WssmT, MTOK, DM, 1024}; pg8::StaticOrder S; S.init(MTOK, DM, G, bx); pg8::EpiYs Ep{P, Mg};
        pg8::gemm_phase<pg8::EpiYs, pg8::StaticOrder, true, true>(lds, g, S, Ep); }
    SEAM(5);
    if (IN(6)) { pg8::Gemm g{Mg, WoutT, MTOK, DM, DM}; pg8::StaticOrder S; S.init(MTOK, DM, G, bx); pg8::EpiOut Ep{a.in[0], a.out};
        pg8::gemm_phase<pg8::EpiOut, pg8::StaticOrder, true, true>(lds, g, S, Ep); }
#undef IN
#undef SEAM
}

extern "C" void kernel_launch(void* const* d_in, const int* in_sizes, int n_in, void* d_out, int out_size, void* d_ws, size_t ws_size, hipStream_t stream) {
    static int grid = 0;
    if (grid == 0) {
        if (n_in != 19 || out_size != MTOK * DM || ws_size < WS_END) { fprintf(stderr, "kernel_launch: unexpected shapes (n_in %d out %d ws %zu)\n", n_in, out_size, ws_size); grid = -1; return; }
        int dev = 0, cus = 0, per_cu = 0;
        (void)hipGetDevice(&dev); (void)hipDeviceGetAttribute(&cus, hipDeviceAttributeMultiprocessorCount, dev);
        (void)hipFuncSetAttribute((const void*)fwd, hipFuncAttributeMaxDynamicSharedMemorySize, LDS_BYTES);
        (void)hipOccupancyMaxActiveBlocksPerMultiprocessor(&per_cu, (const void*)fwd, 512, LDS_BYTES);
        if (per_cu < 1) per_cu = 1;
        grid = cus * per_cu;
        (void)hipGetLastError();
    }
    if (grid < 0) return;
    if (MK_N_LAUNCHES == 1) (void)hipMemsetAsync((unsigned char*)d_ws + WS_BAR, 0, WS_BAR_BYTES, stream);
    Args a{};
    for (int i = 0; i < 19; ++i) a.in[i] = (const float*)d_in[i];
    a.out = (float*)d_out; a.ws = (unsigned char*)d_ws;
#if MK_N_LAUNCHES == 1
    a.ph_lo = 0; a.ph_hi = 7;
    void* args[] = {&a};
    hipError_t e = hipLaunchCooperativeKernel((const void*)fwd, dim3(grid), dim3(512), args, LDS_BYTES, stream);
    if (e != hipSuccess) fprintf(stderr, "cooperative launch failed: %s (grid %d)\n", hipGetErrorString(e), grid);
#else
    for (int ph = 0; ph < 7; ++ph) { a.ph_lo = ph; a.ph_hi = ph + 1; hipLaunchKernelGGL(fwd, dim3(grid), dim3(512), LDS_BYTES, stream, a); }
#endif
}
```

```cpp
#include <hip/hip_runtime.h>
#include <hip/hip_cooperative_groups.h>
#include <cstdio>
#include <cstdint>
namespace cg = cooperative_groups;
namespace pg8 {
#define PG8_LAS __attribute__((address_space(3)))
typedef unsigned short bf16_t;
typedef short bf16x8 __attribute__((ext_vector_type(8)));
typedef float f32x4 __attribute__((ext_vector_type(4)));
typedef unsigned u32x4 __attribute__((ext_vector_type(4)));
constexpr int BM = 256, BK = 64, HALF = 128, HTB = HALF * BK * 2  , STAGE_BYTES = 8 * HTB, NXCD = 8, WGM = 8;

__host__ __device__ __forceinline__ int lds_byte(int r, int c) { const int st = (r >> 4) * 2 + (c >> 5), rr = r & 15, cc = c & 31, ob = rr * 64 + cc * 2; return st * 1024 + (ob ^ (((ob >> 9) & 1) << 5)); }
__host__ __device__ __forceinline__ void stage_rc(int b, int& R, int& C) { const int st = b / 1024, sb = b % 1024, swz = sb ^ (((sb >> 9) & 1) << 5); R = (st >> 1) * 16 + swz / 64; C = (st & 1) * 32 + (swz % 64) / 2; }
__host__ __device__ __forceinline__ int perm32(int rho) { const int n = rho >> 4, i = rho & 15; return 8 * (i >> 2) + 4 * n + (i & 3); }

struct Unit { int pm, pn, w; };
struct Gemm { const bf16_t* A; const bf16_t* Bt; int M, N, K; const bf16_t* A2; const bf16_t* Bt2; };

struct StaticOrder {
    int nM, nN, nwg, G, c;
    __host__ __device__ void init(int M, int N, int G_, int c_) { nM = M / BM; nN = N / BM; nwg = nM * nN; G = G_; c = c_; }
    __host__ __device__ bool next(int i, Unit& u) const {
        const long L = (long)i * G + c; if (L >= nwg) return false;
        int wgid = (int)L; { const int q = nwg / NXCD, r = nwg % NXCD, xcd = wgid % NXCD, off = wgid / NXCD; wgid = (xcd < r ? xcd * (q + 1) : r * (q + 1) + (xcd - r) * q) + off; }
        const int nig = WGM * nN, gid = wgid / nig, fm = gid * WGM, gsz = (nM - fm) < WGM ? (nM - fm) : WGM;
        u.pm = fm + ((wgid % nig) % gsz); u.pn = (wgid % nig) / gsz; u.w = 0; return true;
    }
    __device__ __forceinline__ void a_ready(const Unit&) const {}
    __device__ __forceinline__ void done(const Unit&) const {}
};

__device__ __forceinline__ unsigned cvt_pk_bf16(float lo, float hi) { unsigned r; asm volatile("v_cvt_pk_bf16_f32 %0, %1, %2" : "=v"(r) : "v"(lo), "v"(hi)); return r; }
template <class Epi, class Sched, bool ALIGN_EPI = false, bool SP2 = false>
__device__ __forceinline__ void gemm_phase(PG8_LAS unsigned char* lds, const Gemm g, const Sched& S, const Epi& E) {
    const int tid = threadIdx.x, wid = __builtin_amdgcn_readfirstlane(tid >> 6), lane = tid & 63, wr = wid >> 2, wc = wid & 3, fr = lane & 15, fq = lane >> 4;
    const int K = g.K, nt = K / BK;
    unsigned voffA[2], voffB[2];
#pragma unroll
    for (int i = 0; i < 2; ++i) { int R, C; stage_rc(tid * 16 + i * 8192, R, C); const int Rb = Epi::PERM ? ((R & ~31) + perm32(R & 31)) : R;
        voffA[i] = (unsigned)(R * K + C) * 2u; voffB[i] = (unsigned)(Rb * K + C) * 2u; }
    const size_t kstep = (size_t)(BK * 2);
    const size_t hstep = (size_t)HALF * K * 2;
    const size_t tstep = 2 * hstep;
    const unsigned ldsw = (unsigned)wid * 1024u;
    const int aoff = lds_byte(wr * 64 + fr, fq * 8), boff = lds_byte(wc * 32 + fr, fq * 8);
#define PG8_SA(b, h) (((b) * 2 + (h)) * HTB)
#define PG8_SB(b, h) ((4 + (b) * 2 + (h)) * HTB)
#define PG8_STAGE(bufoff, gbase, voff) do { _Pragma("unroll") for (int _i = 0; _i < 2; ++_i) \
        __builtin_amdgcn_global_load_lds((const unsigned*)((const char*)(gbase) + (voff)[_i]), (PG8_LAS unsigned*)(lds + (bufoff) + ldsw + _i * 8192), 16, 0, 0); } while (0)
#define PG8_LDA(dst, b, h) do { _Pragma("unroll") for (int m = 0; m < 4; ++m) _Pragma("unroll") for (int k = 0; k < 2; ++k) dst[m][k] = *(const PG8_LAS bf16x8*)(lds + PG8_SA(b, h) + aoff + m * 2048 + k * 1024); } while (0)
#define PG8_LDB(dst, b, h) do { _Pragma("unroll") for (int n = 0; n < 2; ++n) _Pragma("unroll") for (int k = 0; k < 2; ++k) dst[n][k] = *(const PG8_LAS bf16x8*)(lds + PG8_SB(b, h) + boff + n * 2048 + k * 1024); } while (0)
#define PG8_MMA(ai, bj, At, Bt) do { __builtin_amdgcn_s_setprio(1); _Pragma("unroll") for (int m = 0; m < 4; ++m) _Pragma("unroll") for (int n = 0; n < 2; ++n) _Pragma("unroll") for (int k = 0; k < 2; ++k) \
        acc[ai][bj][m][n] = __builtin_amdgcn_mfma_f32_16x16x32_bf16(Bt[n][k], At[m][k], acc[ai][bj][m][n], 0, 0, 0); __builtin_amdgcn_s_setprio(0); } while (0)
#define PG8_WAIT_V(n) asm volatile("s_waitcnt vmcnt(" #n ")" ::: "memory")
#define PG8_WAIT_L(n) asm volatile("s_waitcnt lgkmcnt(" #n ")" ::: "memory")
#define PG8_BAR __builtin_amdgcn_s_barrier()
#define PG8_SCHED __builtin_amdgcn_sched_barrier(0)
    Unit cur, nxt; int ui = 0;
    if (!S.next(0, cur)) return;
    f32x4 acc[2][2][4][2];
#pragma unroll
    for (int a = 0; a < 2; ++a)
#pragma unroll
        for (int b = 0; b < 2; ++b)
#pragma unroll
            for (int m = 0; m < 4; ++m)
#pragma unroll
                for (int n = 0; n < 2; ++n) acc[a][b][m][n] = (f32x4){0.f, 0.f, 0.f, 0.f};
    bf16x8 At[4][2], B0[2][2], B1[2][2];
    const char* cA = (const char*)((Epi::DUAL && cur.w) ? g.A2 : g.A) + (size_t)cur.pm * tstep; const char* cB = (const char*)((Epi::DUAL && cur.w) ? g.Bt2 : g.Bt) + (size_t)cur.pn * tstep;
    S.a_ready(cur);
    if constexpr (SP2) {
        PG8_STAGE(PG8_SB(0, 0), cB, voffB); PG8_STAGE(PG8_SB(0, 1), cB + hstep, voffB); PG8_STAGE(PG8_SA(0, 0), cA, voffA); PG8_STAGE(PG8_SA(0, 1), cA + hstep, voffA);
        if (wr == 1) PG8_BAR;
        PG8_WAIT_V(2); PG8_BAR;
        PG8_STAGE(PG8_SB(1, 0), cB + kstep, voffB); PG8_STAGE(PG8_SA(1, 0), cA + kstep, voffA); PG8_STAGE(PG8_SB(1, 1), cB + hstep + kstep, voffB);
        PG8_WAIT_V(6); PG8_BAR;
    } else {
        PG8_STAGE(PG8_SB(0, 0), cB, voffB); PG8_STAGE(PG8_SA(0, 0), cA, voffA); PG8_STAGE(PG8_SB(0, 1), cB + hstep, voffB); PG8_STAGE(PG8_SA(0, 1), cA + hstep, voffA);
        if (wr == 1) PG8_BAR;
        PG8_WAIT_V(4); PG8_BAR;
        PG8_STAGE(PG8_SB(1, 0), cB + kstep, voffB); PG8_STAGE(PG8_SA(1, 0), cA + kstep, voffA); PG8_STAGE(PG8_SB(1, 1), cB + hstep + kstep, voffB);
        PG8_WAIT_V(6); PG8_BAR;
    }
    for (;;) {
        const bool has_next = S.next(ui + 1, nxt);
        const char* nA = has_next ? (const char*)((Epi::DUAL && nxt.w) ? g.A2 : g.A) + (size_t)nxt.pm * tstep : cA; const char* nB = has_next ? (const char*)((Epi::DUAL && nxt.w) ? g.Bt2 : g.Bt) + (size_t)nxt.pn * tstep : cB;
        for (int t = 0; t < nt; t += 2) {
            const bool last = (t == nt - 2);
            const char* a1 = cA + (size_t)(t + 1) * kstep;
            const char* a2 = last ? nA : cA + (size_t)(t + 2) * kstep; const char* b2 = last ? nB : cB + (size_t)(t + 2) * kstep;
            const char* a3 = a2 + kstep; const char* b3 = b2 + kstep;
            if (last && has_next) S.a_ready(nxt);
            if constexpr (SP2) {
            PG8_LDB(B0, 0, 0); PG8_LDB(B1, 0, 1); PG8_SCHED; PG8_LDA(At, 0, 0); PG8_STAGE(PG8_SA(1, 1), a1 + hstep, voffA);
            PG8_WAIT_V(8); PG8_WAIT_L(0); PG8_BAR; PG8_MMA(0, 0, At, B0); PG8_MMA(0, 1, At, B1); PG8_BAR; PG8_SCHED;
            PG8_LDA(At, 0, 1); PG8_STAGE(PG8_SB(0, 0), b2, voffB); PG8_STAGE(PG8_SB(0, 1), b2 + hstep, voffB); PG8_STAGE(PG8_SA(0, 0), a2, voffA);
            PG8_WAIT_V(8); PG8_WAIT_L(0); PG8_BAR; PG8_MMA(1, 0, At, B0); PG8_MMA(1, 1, At, B1); PG8_BAR; PG8_SCHED;
            PG8_LDB(B0, 1, 0); PG8_LDB(B1, 1, 1); PG8_SCHED; PG8_LDA(At, 1, 0); PG8_STAGE(PG8_SA(0, 1), a2 + hstep, voffA);
            PG8_WAIT_V(8); PG8_WAIT_L(0); PG8_BAR; PG8_MMA(0, 0, At, B0); PG8_MMA(0, 1, At, B1); PG8_BAR; PG8_SCHED;
            PG8_LDA(At, 1, 1); PG8_STAGE(PG8_SB(1, 0), b3, voffB); PG8_STAGE(PG8_SB(1, 1), b3 + hstep, voffB); PG8_STAGE(PG8_SA(1, 0), a3, voffA);
            PG8_WAIT_V(8); PG8_WAIT_L(0); PG8_BAR; PG8_MMA(1, 0, At, B0); PG8_MMA(1, 1, At, B1); PG8_BAR; PG8_SCHED;
            } else {
            PG8_LDB(B0, 0, 0); PG8_SCHED; PG8_LDA(At, 0, 0); PG8_STAGE(PG8_SA(1, 1), a1 + hstep, voffA);
            PG8_WAIT_L(8); PG8_BAR; PG8_WAIT_L(0); PG8_MMA(0, 0, At, B0); PG8_BAR; PG8_SCHED;
            PG8_LDB(B1, 0, 1); PG8_STAGE(PG8_SB(0, 0), b2, voffB);
            PG8_BAR; PG8_WAIT_L(0); PG8_MMA(0, 1, At, B1); PG8_BAR;
            PG8_LDA(At, 0, 1); PG8_STAGE(PG8_SA(0, 0), a2, voffA);
            PG8_BAR; PG8_WAIT_L(0); PG8_MMA(1, 0, At, B0); PG8_BAR; PG8_SCHED;
            PG8_STAGE(PG8_SB(0, 1), b2 + hstep, voffB);
            PG8_WAIT_V(6); PG8_BAR; PG8_MMA(1, 1, At, B1); PG8_BAR;
            PG8_LDB(B0, 1, 0); PG8_SCHED; PG8_LDA(At, 1, 0); PG8_STAGE(PG8_SA(0, 1), a2 + hstep, voffA);
            PG8_WAIT_L(8); PG8_BAR; PG8_WAIT_L(0); PG8_MMA(0, 0, At, B0); PG8_BAR; PG8_SCHED;
            PG8_LDB(B1, 1, 1); PG8_STAGE(PG8_SB(1, 0), b3, voffB);
            PG8_BAR; PG8_WAIT_L(0); PG8_MMA(0, 1, At, B1); PG8_BAR;
            PG8_LDA(At, 1, 1); PG8_STAGE(PG8_SA(1, 0), a3, voffA);
            PG8_BAR; PG8_WAIT_L(0); PG8_MMA(1, 0, At, B0); PG8_BAR; PG8_SCHED;
            PG8_STAGE(PG8_SB(1, 1), b3 + hstep, voffB);
            PG8_WAIT_V(6); PG8_BAR; PG8_MMA(1, 1, At, B1); PG8_BAR;
            }
        }
        if constexpr (ALIGN_EPI) { if (wr == 0) PG8_BAR; }
        if constexpr (!Epi::AFTER_DRAIN) { E(acc, cur, wr, wc, fr, fq); S.done(cur); }
        if (!has_next) break;
        if (!Epi::DUAL || cur.w)
#pragma unroll
        for (int a = 0; a < 2; ++a)
#pragma unroll
            for (int b = 0; b < 2; ++b)
#pragma unroll
                for (int m = 0; m < 4; ++m)
#pragma unroll
                    for (int n = 0; n < 2; ++n) acc[a][b][m][n] = (f32x4){0.f, 0.f, 0.f, 0.f};
        cur = nxt; cA = nA; cB = nB; ++ui;
        if constexpr (ALIGN_EPI) { if (wr == 1) PG8_BAR; }
    }
    PG8_WAIT_V(0);
    if constexpr (!ALIGN_EPI) { if (wr == 0) PG8_BAR; }
    PG8_BAR;
    if constexpr (Epi::AFTER_DRAIN) { E.fused(acc, cur, wr, wc, fr, fq, lds, wid, lane); S.done(cur); }
#undef PG8_SA
#undef PG8_SB
#undef PG8_STAGE
#undef PG8_LDA
#undef PG8_LDB
#undef PG8_MMA
#undef PG8_WAIT_V
#undef PG8_WAIT_L
#undef PG8_BAR
#undef PG8_SCHED
}
}

#ifndef MK_N_LAUNCHES
#define MK_N_LAUNCHES 1
#endif
constexpr int DM = 2048, SEQ = 4096, MTOK = 8192, INW = 8704;
constexpr int C_Q = 0, C_K = 1024, C_V = 1280, C_AG = 1536, C_U = 2560, C_Z = 3584, C_GA = 4608, C_GS = 6656;
constexpr float LOG2E = 1.4426950408889634f;
constexpr size_t MiB = 1u << 20;
constexpr size_t WS_WIN = 0, WS_WATTN = 34 * MiB, WS_WGLU = 38 * MiB, WS_WSSM = 42 * MiB, WS_WOUT = 46 * MiB;
constexpr size_t WS_H = 54 * MiB, WS_ATTNG = 224 * MiB  , WS_YG = 70 * MiB, WS_P = 86 * MiB, WS_MG = 0, WS_BAR = 222 * MiB, WS_BAR_BYTES = 16384, WS_TBQ = 222 * MiB + 65536, WS_TCC = WS_TBQ + 524288, WS_TAB = WS_TCC + 524288, WS_END = 240 * MiB;
constexpr int LDS_CTL = 147200;
constexpr size_t OUT_T = 0, OUT_E = 16 * MiB, OUT_U2 = 32 * MiB;
constexpr int LDS_BYTES = 147456;

#define LAS __attribute__((address_space(3)))
typedef unsigned short bf16_t;
typedef unsigned u32x4 __attribute__((ext_vector_type(4)));
typedef unsigned u32x2 __attribute__((ext_vector_type(2)));
typedef float f32x4 __attribute__((ext_vector_type(4)));
typedef short bf16x8 __attribute__((ext_vector_type(8)));
typedef float f32x2 __attribute__((ext_vector_type(2)));

__device__ __forceinline__ unsigned f2bf(float f) { unsigned u = __builtin_bit_cast(unsigned, f); return (u + 0x7fffu + ((u >> 16) & 1u)) >> 16; }
__device__ __forceinline__ float bf2f(unsigned b) { return __builtin_bit_cast(float, b << 16); }
__device__ __forceinline__ float bflo(unsigned w) { return __builtin_bit_cast(float, w << 16); }
__device__ __forceinline__ float bfhi(unsigned w) { return __builtin_bit_cast(float, w & 0xffff0000u); }
__device__ __forceinline__ unsigned pk2(float lo, float hi) { return pg8::cvt_pk_bf16(lo, hi); }
typedef __bf16 bf16x2_t __attribute__((ext_vector_type(2)));
__device__ __forceinline__ unsigned pk2c(float lo, float hi) { const f32x2 v = {lo, hi}; const bf16x2_t b = __builtin_convertvector(v, bf16x2_t); return __builtin_bit_cast(unsigned, b); }
__device__ __forceinline__ float fsigmoid(float x) { return __builtin_amdgcn_rcpf(1.f + __expf(-x)); }
__device__ __forceinline__ float fsilu(float x) { return x * fsigmoid(x); }
__device__ __forceinline__ float fgelu_tanh(float x) { const float z = 0.7978845608028654f * (x + 0.044715f * x * x * x); return x * fsigmoid(2.f * z); }

namespace pg8 {
struct EpiProj {
    static constexpr bool PERM = true, AFTER_DRAIN = false, DUAL = false;
    bf16_t* O; bf16_t* U2;
    __device__ __forceinline__ void operator()(const f32x4 (&acc)[2][2][4][2], const Unit& u, int wr, int wc, int fr, int fq) const {
        const int pn = u.pn;
        if (pn >= 10 && pn < 14) {
            const int row0 = u.pm * BM + wr * 64 + fr, cu0 = (pn - 10) * BM + wc * 32 + 8 * fq;
#pragma unroll
            for (int ai = 0; ai < 2; ++ai)
#pragma unroll
                for (int m = 0; m < 4; ++m) { const int row = row0 + ai * HALF + m * 16; const int bb = row >> 12, t = row & 4095;
#pragma unroll
                    for (int bj = 0; bj < 2; ++bj) { const f32x4 v0 = acc[ai][bj][m][0], v1 = acc[ai][bj][m][1]; const int cu = cu0 + bj * HALF;
                        u32x4 w; w.x = cvt_pk_bf16(v0[0], v0[1]); w.y = cvt_pk_bf16(v0[2], v0[3]); w.z = cvt_pk_bf16(v1[0], v1[1]); w.w = cvt_pk_bf16(v1[2], v1[3]);
                        *(u32x4*)(U2 + ((size_t)(bb * 64 + (cu >> 4)) * 4096 + t) * 16 + (cu & 15)) = w; } }
            return;
        }
        const int act = (pn >= 18) ? 2 : (((pn >= 6 && pn < 10) || (pn >= 14 && pn < 18)) ? 1 : 0);
        const int row0 = u.pm * BM + wr * 64 + fr, col0 = pn * BM + wc * 32 + 8 * fq;
#pragma unroll
        for (int ai = 0; ai < 2; ++ai)
#pragma unroll
            for (int m = 0; m < 4; ++m) { bf16_t* rowp = O + (size_t)(row0 + ai * HALF + m * 16) * INW + col0;
#pragma unroll
                for (int bj = 0; bj < 2; ++bj) { f32x4 v0 = acc[ai][bj][m][0], v1 = acc[ai][bj][m][1];
                    if (act == 1) {
#pragma unroll
                        for (int i = 0; i < 4; ++i) { v0[i] = fsilu(v0[i]); v1[i] = fsilu(v1[i]); } }
                    else if (act == 2) {
#pragma unroll
                        for (int i = 0; i < 4; ++i) { v0[i] = fsigmoid(v0[i]); v1[i] = fsigmoid(v1[i]); } }
                    u32x4 w; w.x = cvt_pk_bf16(v0[0], v0[1]); w.y = cvt_pk_bf16(v0[2], v0[3]); w.z = cvt_pk_bf16(v1[0], v1[1]); w.w = cvt_pk_bf16(v1[2], v1[3]);
                    *(u32x4*)(rowp + bj * HALF) = w; } }
    }
};
struct EpiYa {
    static constexpr bool PERM = true, AFTER_DRAIN = false, DUAL = false;
    const bf16_t* __restrict__ P; bf16_t* __restrict__ Mg;
    __device__ __forceinline__ void operator()(const f32x4 (&acc)[2][2][4][2], const Unit& u, int wr, int wc, int fr, int fq) const {
        const int row0 = u.pm * BM + wr * 64 + fr, col0 = u.pn * BM + wc * 32 + 8 * fq;
        u32x4 g[2][4][2];
#pragma unroll
        for (int ai = 0; ai < 2; ++ai)
#pragma unroll
            for (int m = 0; m < 4; ++m)
#pragma unroll
                for (int bj = 0; bj < 2; ++bj) g[ai][m][bj] = *(const u32x4*)(P + (size_t)(row0 + ai * HALF + m * 16) * INW + C_GA + col0 + bj * HALF);
#pragma unroll
        for (int ai = 0; ai < 2; ++ai)
#pragma unroll
            for (int m = 0; m < 4; ++m) { const size_t r = (size_t)(row0 + ai * HALF + m * 16);
#pragma unroll
                for (int bj = 0; bj < 2; ++bj) { const f32x4 v0 = acc[ai][bj][m][0], v1 = acc[ai][bj][m][1]; const u32x4 gg = g[ai][m][bj];
                    u32x4 w; w.x = cvt_pk_bf16(v0[0] * bflo(gg.x), v0[1] * bfhi(gg.x)); w.y = cvt_pk_bf16(v0[2] * bflo(gg.y), v0[3] * bfhi(gg.y));
                    w.z = cvt_pk_bf16(v1[0] * bflo(gg.z), v1[1] * bfhi(gg.z)); w.w = cvt_pk_bf16(v1[2] * bflo(gg.w), v1[3] * bfhi(gg.w));
                    *(u32x4*)(Mg + r * DM + col0 + bj * HALF) = w; } }
    }
};
struct EpiGlu {
    static constexpr bool PERM = true, AFTER_DRAIN = false, DUAL = false;
    const bf16_t* __restrict__ P; bf16_t* __restrict__ T; const float* __restrict__ bias;
    __device__ __forceinline__ void operator()(const f32x4 (&acc)[2][2][4][2], const Unit& u, int wr, int wc, int fr, int fq) const {
        const int row0 = u.pm * BM + wr * 64 + fr, col0 = u.pn * HALF + wc * 32 + 8 * fq;
        u32x4 zz[2][4];
#pragma unroll
        for (int ai = 0; ai < 2; ++ai)
#pragma unroll
            for (int m = 0; m < 4; ++m) zz[ai][m] = *(const u32x4*)(P + (size_t)(row0 + ai * HALF + m * 16) * INW + C_Z + col0);
        const f32x4 ba0 = *(const f32x4*)(bias + col0), ba1 = *(const f32x4*)(bias + col0 + 4);
        const f32x4 bb0 = *(const f32x4*)(bias + 1024 + col0), bb1 = *(const f32x4*)(bias + 1024 + col0 + 4);
#pragma unroll
        for (int ai = 0; ai < 2; ++ai)
#pragma unroll
            for (int m = 0; m < 4; ++m) { const size_t r = (size_t)(row0 + ai * HALF + m * 16);
                const f32x4 a0 = acc[ai][0][m][0] + ba0, a1 = acc[ai][0][m][1] + ba1, b0 = acc[ai][1][m][0] + bb0, b1 = acc[ai][1][m][1] + bb1;
                const u32x4 z = zz[ai][m];
                u32x4 w;
                w.x = cvt_pk_bf16(a0[0] * fsigmoid(b0[0]) * bflo(z.x), a0[1] * fsigmoid(b0[1]) * bfhi(z.x));
                w.y = cvt_pk_bf16(a0[2] * fsigmoid(b0[2]) * bflo(z.y), a0[3] * fsigmoid(b0[3]) * bfhi(z.y));
                w.z = cvt_pk_bf16(a1[0] * fsigmoid(b1[0]) * bflo(z.z), a1[1] * fsigmoid(b1[1]) * bfhi(z.z));
                w.w = cvt_pk_bf16(a1[2] * fsigmoid(b1[2]) * bflo(z.w), a1[3] * fsigmoid(b1[3]) * bfhi(z.w));
                *(u32x4*)(T + r * 1024 + col0) = w; }
    }
};
struct EpiYs {
    static constexpr bool PERM = true, AFTER_DRAIN = false, DUAL = false;
    const bf16_t* __restrict__ P; bf16_t* Mg;
    __device__ __forceinline__ void operator()(const f32x4 (&acc)[2][2][4][2], const Unit& u, int wr, int wc, int fr, int fq) const {
        const int row0 = u.pm * BM + wr * 64 + fr, col0 = u.pn * BM + wc * 32 + 8 * fq;
#pragma unroll
        for (int ai = 0; ai < 2; ++ai) {
            u32x4 g[4][2], p[4][2];
#pragma unroll
            for (int m = 0; m < 4; ++m)
#pragma unroll
                for (int bj = 0; bj < 2; ++bj) { const size_t r = (size_t)(row0 + ai * HALF + m * 16);
                    g[m][bj] = *(const u32x4*)(P + r * INW + C_GS + col0 + bj * HALF); p[m][bj] = *(const u32x4*)(Mg + r * DM + col0 + bj * HALF); }
            asm volatile("" ::: "memory");
#pragma unroll
            for (int m = 0; m < 4; ++m) { const size_t r = (size_t)(row0 + ai * HALF + m * 16);
#pragma unroll
                for (int bj = 0; bj < 2; ++bj) { const f32x4 v0 = acc[ai][bj][m][0], v1 = acc[ai][bj][m][1]; const u32x4 gg = g[m][bj], pp = p[m][bj];
                    u32x4 w; w.x = cvt_pk_bf16(bflo(pp.x) + v0[0] * bflo(gg.x), bfhi(pp.x) + v0[1] * bfhi(gg.x)); w.y = cvt_pk_bf16(bflo(pp.y) + v0[2] * bflo(gg.y), bfhi(pp.y) + v0[3] * bfhi(gg.y));
                    w.z = cvt_pk_bf16(bflo(pp.z) + v1[0] * bflo(gg.z), bfhi(pp.z) + v1[1] * bfhi(gg.z)); w.w = cvt_pk_bf16(bflo(pp.w) + v1[2] * bflo(gg.w), bfhi(pp.w) + v1[3] * bfhi(gg.w));
                    *(u32x4*)(Mg + r * DM + col0 + bj * HALF) = w; } }
            asm volatile("" ::: "memory");
        }
    }
};
struct EpiDual {
    static constexpr bool PERM = true, AFTER_DRAIN = false, DUAL = true;
    const bf16_t* __restrict__ P; bf16_t* __restrict__ Mg;
    __device__ __forceinline__ void operator()(f32x4 (&acc)[2][2][4][2], const Unit& u, int wr, int wc, int fr, int fq) const {
        const int row0 = u.pm * BM + wr * 64 + fr, col0 = u.pn * BM + wc * 32 + 8 * fq;
        if (u.w == 0) {
#pragma unroll
            for (int ai = 0; ai < 2; ++ai) {
                u32x4 ga[4][2], gs[4][2];
#pragma unroll
                for (int m = 0; m < 4; ++m)
#pragma unroll
                    for (int bj = 0; bj < 2; ++bj) { const size_t r = (size_t)(row0 + ai * HALF + m * 16);
                        ga[m][bj] = *(const u32x4*)(P + r * INW + C_GA + col0 + bj * HALF); gs[m][bj] = *(const u32x4*)(P + r * INW + C_GS + col0 + bj * HALF); }
#pragma unroll
                for (int m = 0; m < 4; ++m)
#pragma unroll
                    for (int bj = 0; bj < 2; ++bj) { const u32x4 a_ = ga[m][bj], s_ = gs[m][bj]; f32x4& v0 = acc[ai][bj][m][0]; f32x4& v1 = acc[ai][bj][m][1];
                        v0[0] *= bflo(a_.x) * __builtin_amdgcn_rcpf(1e-30f + bflo(s_.x)); v0[1] *= bfhi(a_.x) * __builtin_amdgcn_rcpf(1e-30f + bfhi(s_.x)); v0[2] *= bflo(a_.y) * __builtin_amdgcn_rcpf(1e-30f + bflo(s_.y)); v0[3] *= bfhi(a_.y) * __builtin_amdgcn_rcpf(1e-30f + bfhi(s_.y));
                        v1[0] *= bflo(a_.z) * __builtin_amdgcn_rcpf(1e-30f + bflo(s_.z)); v1[1] *= bfhi(a_.z) * __builtin_amdgcn_rcpf(1e-30f + bfhi(s_.z)); v1[2] *= bflo(a_.w) * __builtin_amdgcn_rcpf(1e-30f + bflo(s_.w)); v1[3] *= bfhi(a_.w) * __builtin_amdgcn_rcpf(1e-30f + bfhi(s_.w)); }
            }
        } else {
#pragma unroll
            for (int ai = 0; ai < 2; ++ai) {
                u32x4 gs[4][2];
#pragma unroll
                for (int m = 0; m < 4; ++m)
#pragma unroll
                    for (int bj = 0; bj < 2; ++bj) gs[m][bj] = *(const u32x4*)(P + (size_t)(row0 + ai * HALF + m * 16) * INW + C_GS + col0 + bj * HALF);
#pragma unroll
                for (int m = 0; m < 4; ++m) { const size_t r = (size_t)(row0 + ai * HALF + m * 16);
#pragma unroll
                    for (int bj = 0; bj < 2; ++bj) { const f32x4 v0 = acc[ai][bj][m][0], v1 = acc[ai][bj][m][1]; const u32x4 gg = gs[m][bj];
                        u32x4 w; w.x = cvt_pk_bf16(v0[0] * bflo(gg.x), v0[1] * bfhi(gg.x)); w.y = cvt_pk_bf16(v0[2] * bflo(gg.y), v0[3] * bfhi(gg.y));
                        w.z = cvt_pk_bf16(v1[0] * bflo(gg.z), v1[1] * bfhi(gg.z)); w.w = cvt_pk_bf16(v1[2] * bflo(gg.w), v1[3] * bfhi(gg.w));
                        *(u32x4*)(Mg + r * DM + col0 + bj * HALF) = w; } }
            }
        }
    }
};
struct EpiOut {
    static constexpr bool PERM = true, AFTER_DRAIN = false, DUAL = false;
    const float* __restrict__ X; float* __restrict__ O;
    __device__ __forceinline__ void operator()(const f32x4 (&acc)[2][2][4][2], const Unit& u, int wr, int wc, int fr, int fq) const {
        const int row0 = u.pm * BM + wr * 64 + fr, col0 = u.pn * BM + wc * 32 + 8 * fq;
#pragma unroll
        for (int ai = 0; ai < 2; ++ai) {
            f32x4 xv[4][2][2];
#pragma unroll
            for (int m = 0; m < 4; ++m)
#pragma unroll
                for (int bj = 0; bj < 2; ++bj) { const size_t off = (size_t)(row0 + ai * HALF + m * 16) * DM + col0 + bj * HALF;
                    xv[m][bj][0] = __builtin_nontemporal_load((const f32x4*)(X + off)); xv[m][bj][1] = __builtin_nontemporal_load((const f32x4*)(X + off + 4)); }
            asm volatile("" ::: "memory");
#pragma unroll
            for (int m = 0; m < 4; ++m)
#pragma unroll
                for (int bj = 0; bj < 2; ++bj) { const size_t off = (size_t)(row0 + ai * HALF + m * 16) * DM + col0 + bj * HALF;
                    __builtin_nontemporal_store(xv[m][bj][0] + acc[ai][bj][m][0], (f32x4*)(O + off)); __builtin_nontemporal_store(xv[m][bj][1] + acc[ai][bj][m][1], (f32x4*)(O + off + 4)); }
            asm volatile("" ::: "memory");
        }
    }
};
}

__device__ __forceinline__ float wave_sum(float v) {
#pragma unroll
    for (int o = 1; o < 64; o <<= 1) v += __shfl_xor(v, o);
    return v;
}
struct Args { const float* in[19]; float* out; unsigned char* ws; int ph_lo, ph_hi; };
constexpr int P0_I_IN = (DM / 64) * (INW / 32), P0_I_A = (1024 / 64) * (2048 / 32), P0_I_O = (2048 / 64) * (2048 / 32);
constexpr int P0_NITEMS = P0_I_IN + 3 * P0_I_A + P0_I_O;
struct P0Item { const float* W; bf16_t* WT; int K, N, k0, n0, d0; };
__device__ __forceinline__ P0Item p0_item(const Args& a, int it) {
    P0Item r; int glu = 0; unsigned char* ws = a.ws;
    if (it < P0_I_IN) { r.W = a.in[2]; r.K = DM; r.N = INW; r.WT = (bf16_t*)(ws + WS_WIN); }
    else { it -= P0_I_IN;
        if (it < P0_I_A) { r.W = a.in[6]; r.K = 1024; r.N = 2048; r.WT = (bf16_t*)(ws + WS_WATTN); }
        else { it -= P0_I_A;
            if (it < P0_I_A) { r.W = a.in[15]; r.K = 1024; r.N = 2048; r.WT = (bf16_t*)(ws + WS_WGLU); glu = 1; }
            else { it -= P0_I_A;
                if (it < P0_I_A) { r.W = a.in[17]; r.K = 1024; r.N = 2048; r.WT = (bf16_t*)(ws + WS_WSSM); }
                else { it -= P0_I_A; r.W = a.in[18]; r.K = 2048; r.N = 2048; r.WT = (bf16_t*)(ws + WS_WOUT); } } } }
    const int nblk = r.N / 32, kb = it / nblk, nb = it % nblk; r.k0 = 64 * kb; r.n0 = 32 * nb;
    r.d0 = glu ? ((r.n0 < 1024) ? (256 * (r.n0 >> 7) + (r.n0 & 127)) : (256 * ((r.n0 - 1024) >> 7) + 128 + (r.n0 & 127))) : r.n0;
    return r;
}
__device__ __forceinline__ void p0_load(const P0Item& t, f32x4 (&v)[8], int lane) {
#pragma unroll
    for (int i = 0; i < 8; ++i) v[i] = __builtin_nontemporal_load((const f32x4*)(t.W + (size_t)(t.k0 + (lane >> 3) + 8 * i) * t.N + t.n0 + 4 * (lane & 7)));
}
__device__ __forceinline__ void p0_store(const P0Item& t, const f32x4 (&v)[8], LAS float* scr, int lane) {
#pragma unroll
    for (int i = 0; i < 8; ++i) { LAS float* d = scr + ((lane >> 3) + 8 * i) * 33 + 4 * (lane & 7); d[0] = v[i].x; d[1] = v[i].y; d[2] = v[i].z; d[3] = v[i].w; }
    asm volatile("s_waitcnt lgkmcnt(0)" ::: "memory");
    const int c = lane & 7;
#pragma unroll
    for (int j = 0; j < 4; ++j) { const int n = (lane >> 3) + 8 * j; const LAS float* s = scr + (8 * c) * 33 + n;
        u32x4 o; o.x = pk2(s[0 * 33], s[1 * 33]); o.y = pk2(s[2 * 33], s[3 * 33]); o.z = pk2(s[4 * 33], s[5 * 33]); o.w = pk2(s[6 * 33], s[7 * 33]);
        *(u32x4*)(t.WT + (size_t)(t.d0 + n) * t.K + t.k0 + 8 * c) = o; }
    asm volatile("s_waitcnt lgkmcnt(0)" ::: "memory");
}
__device__ __forceinline__ void p0_weights(const Args& a, LAS float* scr, int it_lo, int it_hi, int gw, int nw, int lane) {
    int it = it_lo + gw; if (it >= it_hi) return;
    P0Item cur = p0_item(a, it); f32x4 v[8]; p0_load(cur, v, lane);
    for (;;) {
        const int itn = it + nw; const bool more = itn < it_hi;
        P0Item nxt = cur; f32x4 vn[8];
        if (more) { nxt = p0_item(a, itn); p0_load(nxt, vn, lane); }
        p0_store(cur, v, scr, lane);
        if (!more) break;
        cur = nxt; it = itn;
#pragma unroll
        for (int i = 0; i < 8; ++i) v[i] = vn[i];
    }
}
__device__ __forceinline__ void ssm_table_task(const Args& a, int task, int lane) {
    const int fr = lane & 15, fq = lane >> 4;
    const float* A_re = a.in[7]; const float* A_im = a.in[8]; const float* log_dt = a.in[9]; const float* B_re = a.in[10]; const float* B_im = a.in[11];
    const float* C_re = a.in[12]; const float* C_im = a.in[13];
    const int g = task / 13, sub = task % 13;
    if (sub < 8) {
        const int nt = sub; const int p = 8 * nt + (fr >> 1);
        const float dt = expf(log_dt[g]);
        const float ar = A_re[g * 64 + p], ai = A_im[g * 64 + p];
        const float* br = B_re + ((size_t)(g * 64 + p)) * 16 + 8 * (fq & 1); const float* bi = B_im + ((size_t)(g * 64 + p)) * 16 + 8 * (fq & 1);
        const f32x4 br0 = *(const f32x4*)br, br1 = *(const f32x4*)(br + 4), bi0 = *(const f32x4*)bi, bi1 = *(const f32x4*)(bi + 4);
        const float mag = expf(dt * ar); float sn, cs; sincosf(dt * ai, &sn, &cs);
        const float nr = mag * cs - 1.0f, ni = mag * sn, den = ar * ar + ai * ai; const float cfr = (nr * ar + ni * ai) / den, cfi = (ni * ar - nr * ai) / den;
        const float m0 = (fr & 1) ? cfi : cfr, m1 = (fr & 1) ? cfr : -cfi;
        float v[8];
#pragma unroll
        for (int i = 0; i < 4; ++i) { v[i] = m0 * br0[i] + m1 * bi0[i]; v[4 + i] = m0 * br1[i] + m1 * bi1[i]; }
        if (fq >= 2) {
#pragma unroll
            for (int i = 0; i < 8; ++i) v[i] = v[i] - bf2f(f2bf(v[i])); }
        u32x4 w_; w_.x = pk2(v[0], v[1]); w_.y = pk2(v[2], v[3]); w_.z = pk2(v[4], v[5]); w_.w = pk2(v[6], v[7]);
        ((u32x4*)(a.ws + WS_TBQ))[(g * 8 + nt) * 64 + lane] = w_;
    } else if (sub < 12) {
        const int ks = sub - 8; const size_t co = ((size_t)(g * 16 + fr)) * 64 + 16 * ks + 4 * fq;
        const f32x4 cr = *(const f32x4*)(C_re + co), ci = *(const f32x4*)(C_im + co);
        float v[8] = {cr[0], -ci[0], cr[1], -ci[1], cr[2], -ci[2], cr[3], -ci[3]}; float lo[8];
#pragma unroll
        for (int i = 0; i < 8; ++i) lo[i] = v[i] - bf2f(f2bf(v[i]));
        u32x4 wh, wl_; wh.x = pk2(v[0], v[1]); wh.y = pk2(v[2], v[3]); wh.z = pk2(v[4], v[5]); wh.w = pk2(v[6], v[7]);
        wl_.x = pk2(lo[0], lo[1]); wl_.y = pk2(lo[2], lo[3]); wl_.z = pk2(lo[4], lo[5]); wl_.w = pk2(lo[6], lo[7]);
        ((u32x4*)(a.ws + WS_TCC))[((g * 4 + ks) * 2 + 0) * 64 + lane] = wh; ((u32x4*)(a.ws + WS_TCC))[((g * 4 + ks) * 2 + 1) * 64 + lane] = wl_;
    } else {
        const float dt = expf(log_dt[g]);
        const float ar = A_re[g * 64 + lane], ai = A_im[g * 64 + lane]; const float mag = expf(dt * ar); float sn, cs; sincosf(dt * ai, &sn, &cs);
        ((f32x2*)(a.ws + WS_TAB))[g * 64 + lane] = (f32x2){mag * cs, mag * sn};
    }
}
__device__ __forceinline__ void p0_prologue(const Args& a, LAS unsigned char* lds, int wave, int lane) {
    LAS float* scr = (LAS float*)(lds + wave * 16384);
    const int gw = blockIdx.x * 8 + wave, NGW = gridDim.x * 8;
    unsigned char* ws = a.ws;
    const float* x = a.in[0]; const float* nw = a.in[1]; bf16_t* H = (bf16_t*)(ws + WS_H);
    f32x4 wv[8];
#pragma unroll
    for (int j = 0; j < 8; ++j) wv[j] = *((const f32x4*)nw + lane + 64 * j);
    int m = gw;
    f32x4 v[8];
    if (m < MTOK) {
#pragma unroll
        for (int j = 0; j < 8; ++j) v[j] = __builtin_nontemporal_load((const f32x4*)(x + (size_t)m * DM) + lane + 64 * j); }
    for (int t = gw; t < 64 * 13; t += NGW) ssm_table_task(a, t, lane);
    p0_weights(a, scr, 0, P0_I_IN, gw, NGW, lane);
    if (m >= MTOK) return;
    for (;;) {
        const int mn = m + NGW; const bool more = mn < MTOK; f32x4 vn[8];
        if (more) {
#pragma unroll
            for (int j = 0; j < 8; ++j) vn[j] = __builtin_nontemporal_load((const f32x4*)(x + (size_t)mn * DM) + lane + 64 * j); }
        float s = 0.f;
#pragma unroll
        for (int j = 0; j < 8; ++j) s += (v[j].x * v[j].x + v[j].y * v[j].y) + (v[j].z * v[j].z + v[j].w * v[j].w);
        const float rstd = rsqrtf(wave_sum(s) * (1.f / DM) + 1e-6f);
        u32x2* o8 = (u32x2*)(H + (size_t)m * DM) + lane;
#pragma unroll
        for (int j = 0; j < 8; ++j) { u32x2 o; o.x = pk2(v[j].x * rstd * wv[j].x, v[j].y * rstd * wv[j].y); o.y = pk2(v[j].z * rstd * wv[j].z, v[j].w * rstd * wv[j].w); o8[64 * j] = o; }
        if (!more) break;
        m = mn;
#pragma unroll
        for (int j = 0; j < 8; ++j) v[j] = vn[j];
    }
}

constexpr int KL_STRIDE = 144, VT_STRIDE = 528, KL_BYTES = 256 * KL_STRIDE;
__device__ __forceinline__ void attn_unit(LAS unsigned char* lds, const bf16_t* P, bf16_t* AttnG, const float* qw, const float* kw, const float* sinks, int b, int blk, int g, int tid) {
    const int lane = tid & 63, w = tid >> 6, fr = lane & 15, fq = lane >> 4;
    const long base = (long)b * SEQ + (long)blk * 128;
    LAS unsigned char* Kl = lds; LAS unsigned char* Vt = lds + KL_BYTES;
    const long tok = base + 16 * w + fr;
    u32x4 qraw[4][2]; u32x2 graw[4][4]; u32x4 kraw[4], vraw[4];
    const int c = tid & 7;
#pragma unroll
    for (int i = 0; i < 4; ++i) { int key = (tid >> 3) + 64 * i; if (blk == 0 && key < 128) key += 128;
        kraw[i] = *(const u32x4*)(P + (size_t)(base - 128 + key) * INW + C_K + g * 64 + 8 * c); }
#pragma unroll
    for (int i = 0; i < 4; ++i) { int key = lane + 64 * i; if (blk == 0 && key < 128) key += 128;
        vraw[i] = *(const u32x4*)(P + (size_t)(base - 128 + key) * INW + C_V + g * 64 + 8 * w); }
#pragma unroll
    for (int r = 0; r < 4; ++r) { const int h = 4 * g + r;
        qraw[r][0] = *(const u32x4*)(P + (size_t)tok * INW + C_Q + h * 64 + 8 * fq); qraw[r][1] = *(const u32x4*)(P + (size_t)tok * INW + C_Q + h * 64 + 32 + 8 * fq);
#pragma unroll
        for (int dt = 0; dt < 4; ++dt) graw[r][dt] = *(const u32x2*)(P + (size_t)tok * INW + C_AG + h * 64 + 16 * dt + 4 * fq); }
    const f32x4 kw0 = *(const f32x4*)(kw + 8 * c), kw1 = *(const f32x4*)(kw + 8 * c + 4);
    const f32x4 qwa0 = *(const f32x4*)(qw + 8 * fq), qwa1 = *(const f32x4*)(qw + 8 * fq + 4), qwb0 = *(const f32x4*)(qw + 32 + 8 * fq), qwb1 = *(const f32x4*)(qw + 32 + 8 * fq + 4);
    const f32x4 sk4 = *(const f32x4*)(sinks + 4 * g);
    if (blk == 0) {
#pragma unroll
        for (int i = 0; i < 2; ++i) { kraw[i] = (u32x4){0u, 0u, 0u, 0u}; vraw[i] = (u32x4){0u, 0u, 0u, 0u}; } }
    {
        const f32x4 kw0 = *(const f32x4*)(kw + 8 * c), kw1 = *(const f32x4*)(kw + 8 * c + 4);
#pragma unroll
        for (int i = 0; i < 4; ++i) { const int key = (tid >> 3) + 64 * i; const u32x4 raw = kraw[i];
            float f[8] = {bflo(raw.x), bfhi(raw.x), bflo(raw.y), bfhi(raw.y), bflo(raw.z), bfhi(raw.z), bflo(raw.w), bfhi(raw.w)};
            float ss = 0.f;
#pragma unroll
            for (int e = 0; e < 8; ++e) ss += f[e] * f[e];
            ss += __shfl_xor(ss, 1); ss += __shfl_xor(ss, 2); ss += __shfl_xor(ss, 4);
            const float rstd = rsqrtf(ss * (1.f / 64.f) + 1e-6f);
            u32x4 o; o.x = pk2(f[0] * rstd * kw0[0], f[1] * rstd * kw0[1]); o.y = pk2(f[2] * rstd * kw0[2], f[3] * rstd * kw0[3]);
            o.z = pk2(f[4] * rstd * kw1[0], f[5] * rstd * kw1[1]); o.w = pk2(f[6] * rstd * kw1[2], f[7] * rstd * kw1[3]);
            *(LAS u32x4*)(Kl + key * KL_STRIDE + c * 16) = o; }
#pragma unroll
        for (int i = 0; i < 4; ++i) { const int key = lane + 64 * i; const u32x4 raw = vraw[i];
            LAS unsigned short* vp = (LAS unsigned short*)(Vt + (8 * w) * VT_STRIDE + key * 2);
            vp[0 * (VT_STRIDE / 2)] = (unsigned short)(raw.x & 0xffffu); vp[1 * (VT_STRIDE / 2)] = (unsigned short)(raw.x >> 16);
            vp[2 * (VT_STRIDE / 2)] = (unsigned short)(raw.y & 0xffffu); vp[3 * (VT_STRIDE / 2)] = (unsigned short)(raw.y >> 16);
            vp[4 * (VT_STRIDE / 2)] = (unsigned short)(raw.z & 0xffffu); vp[5 * (VT_STRIDE / 2)] = (unsigned short)(raw.z >> 16);
            vp[6 * (VT_STRIDE / 2)] = (unsigned short)(raw.w & 0xffffu); vp[7 * (VT_STRIDE / 2)] = (unsigned short)(raw.w >> 16); }
    }
    __syncthreads();
#pragma unroll
    for (int r = 0; r < 4; ++r) {
        const int h = 4 * g + r;
        const u32x4 r0 = qraw[r][0], r1 = qraw[r][1];
        float q0[8] = {bflo(r0.x), bfhi(r0.x), bflo(r0.y), bfhi(r0.y), bflo(r0.z), bfhi(r0.z), bflo(r0.w), bfhi(r0.w)};
        float q1[8] = {bflo(r1.x), bfhi(r1.x), bflo(r1.y), bfhi(r1.y), bflo(r1.z), bfhi(r1.z), bflo(r1.w), bfhi(r1.w)};
        float ss = 0.f;
#pragma unroll
        for (int e = 0; e < 8; ++e) ss += q0[e] * q0[e] + q1[e] * q1[e];
        ss += __shfl_xor(ss, 16); ss += __shfl_xor(ss, 32);
        const float qs = rsqrtf(ss * (1.f / 64.f) + 1e-6f) * (0.125f * LOG2E);
        u32x4 qa, qb;
        qa.x = pk2(q0[0] * qs * qwa0[0], q0[1] * qs * qwa0[1]); qa.y = pk2(q0[2] * qs * qwa0[2], q0[3] * qs * qwa0[3]); qa.z = pk2(q0[4] * qs * qwa1[0], q0[5] * qs * qwa1[1]); qa.w = pk2(q0[6] * qs * qwa1[2], q0[7] * qs * qwa1[3]);
        qb.x = pk2(q1[0] * qs * qwb0[0], q1[1] * qs * qwb0[1]); qb.y = pk2(q1[2] * qs * qwb0[2], q1[3] * qs * qwb0[3]); qb.z = pk2(q1[4] * qs * qwb1[0], q1[5] * qs * qwb1[1]); qb.w = pk2(q1[6] * qs * qwb1[2], q1[7] * qs * qwb1[3]);
        const bf16x8 qf0 = __builtin_bit_cast(bf16x8, qa), qf1 = __builtin_bit_cast(bf16x8, qb);
        f32x4 s[9];
#pragma unroll
        for (int tt = 0; tt < 9; ++tt) { const LAS unsigned char* kp = Kl + (16 * (w + tt) + fr) * KL_STRIDE + 16 * fq;
            const bf16x8 a0 = *(const LAS bf16x8*)kp, a1 = *(const LAS bf16x8*)(kp + 64);
            f32x4 z = (f32x4){0.f, 0.f, 0.f, 0.f};
            z = __builtin_amdgcn_mfma_f32_16x16x32_bf16(a0, qf0, z, 0, 0, 0); s[tt] = __builtin_amdgcn_mfma_f32_16x16x32_bf16(a1, qf1, z, 0, 0, 0); }
        const float sink2 = sk4[r] * LOG2E; float mx = sink2;
#pragma unroll
        for (int tt = 0; tt < 9; ++tt)
#pragma unroll
            for (int j = 0; j < 4; ++j) { const int diff = 128 + fr - 16 * tt - 4 * fq - j; const bool ok = (diff >= 0) && (diff < 128) && (blk > 0 || (w + tt) >= 8);
                s[tt][j] = ok ? s[tt][j] : -INFINITY; mx = fmaxf(mx, s[tt][j]); }
        mx = fmaxf(mx, __shfl_xor(mx, 16)); mx = fmaxf(mx, __shfl_xor(mx, 32));
        float l = 0.f;
#pragma unroll
        for (int tt = 0; tt < 9; ++tt)
#pragma unroll
            for (int j = 0; j < 4; ++j) { s[tt][j] = __builtin_amdgcn_exp2f(s[tt][j] - mx); l += s[tt][j]; }
        l += __shfl_xor(l, 16); l += __shfl_xor(l, 32); l += __builtin_amdgcn_exp2f(sink2 - mx);
        const float inv = 1.f / l;
        f32x4 o[4];
#pragma unroll
        for (int dt = 0; dt < 4; ++dt) o[dt] = (f32x4){0.f, 0.f, 0.f, 0.f};
#pragma unroll
        for (int cc = 0; cc < 5; ++cc) { const int T1 = w + 2 * cc; const int T2c = (T1 + 1 > 15) ? 15 : (T1 + 1);
            u32x4 pw; pw.x = pk2(s[2 * cc][0], s[2 * cc][1]); pw.y = pk2(s[2 * cc][2], s[2 * cc][3]);
            if (cc < 4) { pw.z = pk2(s[2 * cc + 1 > 8 ? 8 : 2 * cc + 1][0], s[2 * cc + 1 > 8 ? 8 : 2 * cc + 1][1]); pw.w = pk2(s[2 * cc + 1 > 8 ? 8 : 2 * cc + 1][2], s[2 * cc + 1 > 8 ? 8 : 2 * cc + 1][3]); } else { pw.z = 0u; pw.w = 0u; }
            const bf16x8 pf = __builtin_bit_cast(bf16x8, pw);
#pragma unroll
            for (int dt = 0; dt < 4; ++dt) { const LAS unsigned char* vp = Vt + (16 * dt + fr) * VT_STRIDE;
                const u32x2 lo = *(const LAS u32x2*)(vp + (16 * T1 + 4 * fq) * 2), hi = *(const LAS u32x2*)(vp + (16 * T2c + 4 * fq) * 2);
                u32x4 av; av.x = lo.x; av.y = lo.y; av.z = hi.x; av.w = hi.y;
                o[dt] = __builtin_amdgcn_mfma_f32_16x16x32_bf16(__builtin_bit_cast(bf16x8, av), pf, o[dt], 0, 0, 0); } }
#pragma unroll
        for (int dt = 0; dt < 4; ++dt) { const int col = h * 64 + 16 * dt + 4 * fq;
            const u32x2 gt = graw[r][dt];
            u32x2 ov; ov.x = pk2(o[dt][0] * inv * bflo(gt.x), o[dt][1] * inv * bfhi(gt.x)); ov.y = pk2(o[dt][2] * inv * bflo(gt.y), o[dt][3] * inv * bfhi(gt.y));
            *(u32x2*)(AttnG + (size_t)tok * 1024 + col) = ov; }
    }
    __syncthreads();
}

constexpr int SW_RS = 68, SW_TILE = 16 * SW_RS * 4, SW_BYTES = 2 * SW_TILE;
constexpr int SSM_CH = 256, SSM_NCH = SEQ / SSM_CH, SSM_NST = SSM_CH / 16, SSM_ITEMS = 2 * 64 * SSM_NCH;
template <bool PASSB>
__device__ __forceinline__ void ssm_item(LAS unsigned char* wl, const Args& a, const bf16_t* P, float* E, bf16_t* Yg, int b, int g, int c, int lane) {
    const int fr = lane & 15, fq = lane >> 4;
    const float* D_skip = a.in[14];
    const f32x2 ab = ((const f32x2*)(a.ws + WS_TAB))[g * 64 + lane]; const float abr = ab.x, abi = ab.y;
    bf16x8 bq[8];
#pragma unroll
    for (int nt = 0; nt < 8; ++nt) bq[nt] = __builtin_bit_cast(bf16x8, ((const u32x4*)(a.ws + WS_TBQ))[(g * 8 + nt) * 64 + lane]);
    bf16x8 cch[4]; float dsk[4];
    if (PASSB) {
#pragma unroll
        for (int ks = 0; ks < 4; ++ks) cch[ks] = __builtin_bit_cast(bf16x8, ((const u32x4*)(a.ws + WS_TCC))[((g * 4 + ks) * 2 + 0) * 64 + lane]);
        const f32x4 dv = *(const f32x4*)(D_skip + g * 16 + 4 * fq); dsk[0] = dv[0]; dsk[1] = dv[1]; dsk[2] = dv[2]; dsk[3] = dv[3];
    }
    const long tok0 = (long)b * SEQ + (long)c * SSM_CH;
    const bf16_t* ub = P + ((size_t)(b * 64 + g) * 4096 + (size_t)c * SSM_CH + fr) * 16;
    float sr = 0.f, si = 0.f;
    if (PASSB) {
        const float* Eb = E + ((size_t)(b * 64 + g) * SSM_NCH) * 128;
        float pr = abr, pi = abi;
#pragma unroll
        for (int i = 0; i < 8; ++i) { const float nr = pr * pr - pi * pi, ni = 2.f * pr * pi; pr = nr; pi = ni; }
        float er[SSM_NCH - 1], ei[SSM_NCH - 1];
#pragma unroll
        for (int cp = 0; cp < SSM_NCH - 1; ++cp) { er[cp] = 0.f; ei[cp] = 0.f; if (cp < c) { er[cp] = Eb[(size_t)cp * 128 + lane]; ei[cp] = Eb[(size_t)cp * 128 + 64 + lane]; } }
#pragma unroll
        for (int cp = 0; cp < SSM_NCH - 1; ++cp) if (cp < c) { const float nr = fmaf(pr, sr, fmaf(-pi, si, er[cp])), ni = fmaf(pr, si, fmaf(pi, sr, ei[cp])); sr = nr; si = ni; }
    }
    LAS float* W0 = (LAS float*)wl; LAS float* W1 = (LAS float*)(wl + SW_TILE);
    u32x4 uc0 = *(const u32x4*)(ub + 8 * (fq & 1)), uc1 = *(const u32x4*)(ub + 256 + 8 * (fq & 1));
    u32x2 vc0 = (u32x2){0u, 0u}, vc1 = (u32x2){0u, 0u};
    if (PASSB) { vc0 = *(const u32x2*)(ub + 4 * fq); vc1 = *(const u32x2*)(ub + 256 + 4 * fq); }
#pragma unroll 1
    for (int sp = 0; sp < SSM_NST / 2; ++sp) {
        const int spn = (sp + 1 < SSM_NST / 2) ? sp + 1 : sp;
        const u32x4 un0 = *(const u32x4*)(ub + (size_t)spn * 512 + 8 * (fq & 1)), un1 = *(const u32x4*)(ub + (size_t)spn * 512 + 256 + 8 * (fq & 1));
        u32x2 vn0 = (u32x2){0u, 0u}, vn1 = (u32x2){0u, 0u};
        if (PASSB) { vn0 = *(const u32x2*)(ub + (size_t)spn * 512 + 4 * fq); vn1 = *(const u32x2*)(ub + (size_t)spn * 512 + 256 + 4 * fq); }
        const bf16x8 uf0 = __builtin_bit_cast(bf16x8, uc0), uf1 = __builtin_bit_cast(bf16x8, uc1);
#pragma unroll
        for (int nt = 0; nt < 8; ++nt) { const f32x4 z = (f32x4){0.f, 0.f, 0.f, 0.f};
            const f32x4 r0 = __builtin_amdgcn_mfma_f32_16x16x32_bf16(bq[nt], uf0, z, 0, 0, 0);
            const f32x4 r1 = __builtin_amdgcn_mfma_f32_16x16x32_bf16(bq[nt], uf1, z, 0, 0, 0);
            u32x2 k0, k1; k0.x = pk2c(r0[0], r0[1]); k0.y = pk2c(r0[2], r0[3]); k1.x = pk2c(r1[0], r1[1]); k1.y = pk2c(r1[2], r1[3]);
            *(LAS u32x2*)((LAS unsigned*)W0 + fr * SW_RS + 8 * nt + 2 * fq) = k0; *(LAS u32x2*)((LAS unsigned*)W1 + fr * SW_RS + 8 * nt + 2 * fq) = k1; }
        asm volatile("s_waitcnt lgkmcnt(0)" ::: "memory");
        f32x2 b0[16], b1[16];
#pragma unroll
        for (int t = 0; t < 16; ++t) { const unsigned q0 = ((const LAS unsigned*)W0)[t * SW_RS + lane], q1 = ((const LAS unsigned*)W1)[t * SW_RS + lane];
            b0[t] = (f32x2){bflo(q0), bfhi(q0)}; b1[t] = (f32x2){bflo(q1), bfhi(q1)}; }
        asm volatile("s_waitcnt lgkmcnt(0)" ::: "memory");
#pragma unroll
        for (int t = 0; t < 16; ++t) {
            const float nr = fmaf(abr, sr, fmaf(-abi, si, b0[t].x)), ni = fmaf(abr, si, fmaf(abi, sr, b0[t].y)); sr = nr; si = ni;
            if (PASSB) ((LAS unsigned*)W0)[t * SW_RS + lane] = pk2(sr, si); }
#pragma unroll
        for (int t = 0; t < 16; ++t) {
            const float nr = fmaf(abr, sr, fmaf(-abi, si, b1[t].x)), ni = fmaf(abr, si, fmaf(abi, sr, b1[t].y)); sr = nr; si = ni;
            if (PASSB) ((LAS unsigned*)W1)[t * SW_RS + lane] = pk2(sr, si); }
        if (PASSB) {
            asm volatile("s_waitcnt lgkmcnt(0)" ::: "memory");
            f32x4 y0 = (f32x4){0.f, 0.f, 0.f, 0.f}, y1 = (f32x4){0.f, 0.f, 0.f, 0.f};
#pragma unroll
            for (int ks = 0; ks < 4; ++ks) { const bf16x8 f0 = *(const LAS bf16x8*)((LAS unsigned*)W0 + fr * SW_RS + 16 * ks + 4 * fq), f1 = *(const LAS bf16x8*)((LAS unsigned*)W1 + fr * SW_RS + 16 * ks + 4 * fq);
                y0 = __builtin_amdgcn_mfma_f32_16x16x32_bf16(cch[ks], f0, y0, 0, 0, 0);
                y1 = __builtin_amdgcn_mfma_f32_16x16x32_bf16(cch[ks], f1, y1, 0, 0, 0); }
            { const float q0 = fgelu_tanh(y0[0] + dsk[0] * bflo(vc0.x)), q1 = fgelu_tanh(y0[1] + dsk[1] * bfhi(vc0.x)), q2 = fgelu_tanh(y0[2] + dsk[2] * bflo(vc0.y)), q3 = fgelu_tanh(y0[3] + dsk[3] * bfhi(vc0.y));
              u32x2 ov; ov.x = pk2(q0, q1); ov.y = pk2(q2, q3); *(u32x2*)(Yg + (size_t)(tok0 + 32 * sp + fr) * 1024 + 16 * g + 4 * fq) = ov; }
            { const float q0 = fgelu_tanh(y1[0] + dsk[0] * bflo(vc1.x)), q1 = fgelu_tanh(y1[1] + dsk[1] * bfhi(vc1.x)), q2 = fgelu_tanh(y1[2] + dsk[2] * bflo(vc1.y)), q3 = fgelu_tanh(y1[3] + dsk[3] * bfhi(vc1.y));
              u32x2 ov; ov.x = pk2(q0, q1); ov.y = pk2(q2, q3); *(u32x2*)(Yg + (size_t)(tok0 + 32 * sp + 16 + fr) * 1024 + 16 * g + 4 * fq) = ov; }
            asm volatile("s_waitcnt lgkmcnt(0)" ::: "memory");
        }
        asm volatile("" ::: "memory");
        uc0 = un0; uc1 = un1; vc0 = vn0; vc1 = vn1;
    }
    if (!PASSB) { float* Eo = E + ((size_t)((b * 64 + g) * SSM_NCH + c)) * 128; Eo[lane] = sr; Eo[64 + lane] = si; }
}

#define XB_TMO      128
#define XB_XCNT(j)  (256  + 64 * (j))
#define XB_XSUB(j)  (1280 + 64 * (j))
#define XB_XGEN(j)  (2304 + 64 * (j))
#define XB_TOP      3328
#define XB_TOPGEN   3392
#define XCD_BAR_WORDS 3456
#define XB_SPIN_CAP (1u << 18)

__device__ __forceinline__ unsigned xb_ld(unsigned* p)              { return __hip_atomic_load(p, __ATOMIC_RELAXED, __HIP_MEMORY_SCOPE_AGENT); }
__device__ __forceinline__ unsigned xb_add(unsigned* p, unsigned v) { return __hip_atomic_fetch_add(p, v, __ATOMIC_RELAXED, __HIP_MEMORY_SCOPE_AGENT); }
__device__ __forceinline__ unsigned xb_xcc_id() { return (unsigned)__builtin_amdgcn_s_getreg((3 << 11) | 20) & 0xFu; }
#define XB_SPIN(cond, bar) do { unsigned _sp = 0; while (cond) { __builtin_amdgcn_s_sleep(1); \
    if ((++_sp & 255u) == 0u) { if (xb_ld(&(bar)[XB_TMO])) break; if (_sp > XB_SPIN_CAP) { atomicAdd(&(bar)[XB_TMO], 1u); break; } } } } while (0)

struct XcdBarrier {
    unsigned* bar; unsigned x;
    volatile LAS unsigned* st;
};

__device__ __forceinline__ XcdBarrier xcd_barrier_post(unsigned* bar, volatile LAS unsigned* st) {
    XcdBarrier b; b.bar = bar; b.x = xb_xcc_id(); b.st = st;
    if (threadIdx.x == 0) (void)xb_add(&bar[XB_XCNT(b.x)], 1u);
    return b;
}
__device__ __forceinline__ void xcd_barrier_complete(unsigned* bar, unsigned x, unsigned& nloc, unsigned& nx) {
    const unsigned G = gridDim.x * gridDim.y * gridDim.z;
    unsigned sum, cnt, mine, sp = 0u;
    for (;;) {
        sum = 0u; cnt = 0u; mine = 0u;
#pragma unroll
        for (unsigned j = 0; j < 16; ++j) { const unsigned c = xb_ld(&bar[XB_XCNT(j)]); sum += c; cnt += (c > 0u) ? 1u : 0u; mine = (j == x) ? c : mine; }
        if (sum == G) break;
        __builtin_amdgcn_s_sleep(1);
        if ((++sp & 255u) == 0u) { if (xb_ld(&bar[XB_TMO])) break; if (sp > XB_SPIN_CAP) { atomicAdd(&bar[XB_TMO], 1u); break; } }
    }
    nloc = mine > 0u ? mine : 1u; nx = cnt > 0u ? cnt : 1u;
}

__device__ __forceinline__ void xcd_barrier(const XcdBarrier& b) {
    asm volatile("s_waitcnt vmcnt(0)" ::: "memory");
    __syncthreads();
    if (threadIdx.x == 0) {
        unsigned* bar = b.bar;
        __builtin_amdgcn_s_waitcnt(0);
        unsigned nloc = b.st[0], nx = b.st[1];
        if (nloc == 0u) { xcd_barrier_complete(bar, b.x, nloc, nx); b.st[0] = nloc; b.st[1] = nx; }
        const unsigned old = xb_add(&bar[XB_XSUB(b.x)], 1u);
        const unsigned gen = old / nloc;
        if (old + 1u == (gen + 1u) * nloc) {
            __builtin_amdgcn_fence(__ATOMIC_RELEASE, "agent");
            asm volatile("s_waitcnt vmcnt(0)" ::: "memory");
            const unsigned og = xb_add(&bar[XB_TOP], 1u);
            const unsigned tg = og / nx;
            if (og + 1u == (tg + 1u) * nx) xb_add(&bar[XB_TOPGEN], 1u);
            else XB_SPIN(xb_ld(&bar[XB_TOPGEN]) == tg, bar);
            __builtin_amdgcn_fence(__ATOMIC_ACQUIRE, "agent");
            xb_add(&bar[XB_XGEN(b.x)], 1u);
            asm volatile("s_waitcnt vmcnt(0)" ::: "memory");
        } else {
            XB_SPIN(xb_ld(&bar[XB_XGEN(b.x)]) == gen, bar);
            __builtin_amdgcn_fence(__ATOMIC_ACQUIRE, "agent");
            asm volatile("s_waitcnt vmcnt(0)" ::: "memory");
        }
    }
    __syncthreads();
}


#define EB_CNT  3520
#define EB_WORK 3584
#define EB_CNT2 3648
__device__ __forceinline__ void eb_arrive(unsigned* bar) {
    __builtin_amdgcn_fence(__ATOMIC_RELEASE, "agent");
    asm volatile("s_waitcnt vmcnt(0)" ::: "memory");
    (void)xb_add(&bar[EB_CNT], 1u);
}
__device__ __forceinline__ void eb_wait(unsigned* bar, unsigned want) {
    if (threadIdx.x == 0) {
        XB_SPIN(xb_ld(&bar[EB_CNT]) < want, bar);
        __builtin_amdgcn_fence(__ATOMIC_ACQUIRE, "agent");
        asm volatile("s_waitcnt vmcnt(0)" ::: "memory");
    }
    __syncthreads();
}
namespace pg8 {
struct OrderDual : StaticOrder {
    unsigned* bar; unsigned want;
    __device__ __forceinline__ bool next(int i, Unit& u) const { const bool ok = StaticOrder::next(i >> 1, u); u.w = i & 1; return ok; }
    __device__ __forceinline__ void a_ready(const Unit& u) const {
        if (u.w == 1) {
            if (threadIdx.x < 64) {
                unsigned sp = 0;
                while ((unsigned)__builtin_amdgcn_readfirstlane(xb_ld(&bar[EB_CNT2])) < want) { __builtin_amdgcn_s_sleep(2); if (++sp > (1u << 22)) break; }
                __builtin_amdgcn_fence(__ATOMIC_ACQUIRE, "agent");
                asm volatile("s_waitcnt vmcnt(0)" ::: "memory");
            }
            asm volatile("" ::: "memory"); __builtin_amdgcn_s_barrier(); asm volatile("" ::: "memory");
        }
    }
};
struct OrderP1 : StaticOrder {
    int pm3, pn3; unsigned* bar;
    __device__ __forceinline__ void done(const Unit& u) const {
        if (u.pm == pm3 && u.pn == pn3) {
            asm volatile("s_waitcnt vmcnt(0)" ::: "memory"); __builtin_amdgcn_s_barrier();
            if (threadIdx.x == 0) eb_arrive(bar);
        }
    }
};
}

__global__ void __launch_bounds__(512, 2) fwd(Args a) {
    extern __shared__ __attribute__((aligned(16))) unsigned char lds_raw[];
    LAS unsigned char* lds = (LAS unsigned char*)lds_raw;
    cg::grid_group grid = cg::this_grid();
    const int tid = threadIdx.x, lane = tid & 63, wave = __builtin_amdgcn_readfirstlane(tid >> 6);
    const int G = gridDim.x, bx = blockIdx.x;
    unsigned char* ws = a.ws;
    bf16_t* WinT = (bf16_t*)(ws + WS_WIN); bf16_t* WattnT = (bf16_t*)(ws + WS_WATTN); bf16_t* WgluT = (bf16_t*)(ws + WS_WGLU); bf16_t* WssmT = (bf16_t*)(ws + WS_WSSM); bf16_t* WoutT = (bf16_t*)(ws + WS_WOUT);
    bf16_t* H = (bf16_t*)(ws + WS_H); bf16_t* AttnG = (bf16_t*)(ws + WS_ATTNG); bf16_t* Yg = (bf16_t*)(ws + WS_YG); bf16_t* P = (bf16_t*)(ws + WS_P); bf16_t* Mg = (bf16_t*)(ws + WS_MG);
    bf16_t* T = (bf16_t*)((unsigned char*)a.out + OUT_T); float* E = (float*)((unsigned char*)a.out + OUT_E); bf16_t* U2 = (bf16_t*)((unsigned char*)a.out + OUT_U2);
    const int lo = a.ph_lo, hi = a.ph_hi;
#define IN(k) (lo <= (k) && (k) < hi)
    if (tid < 16) ((LAS unsigned*)(lds + LDS_CTL))[tid] = 0u;
    __syncthreads();
    XcdBarrier bar = xcd_barrier_post((unsigned*)(ws + WS_BAR), (volatile LAS unsigned*)(lds + LDS_CTL) + 8);
    if (hi == 99) grid.sync();
#define SEAM(k) do { if (IN(k) && IN((k) + 1)) xcd_barrier(bar); } while (0)

    if (IN(0)) { p0_prologue(a, lds, wave, lane); __syncthreads(); }
    SEAM(0);
    const bool fuse12 = (lo == 0 && hi == 7 && G == 256);
    if (fuse12) {
        unsigned* bw = (unsigned*)(ws + WS_BAR);
        { pg8::Gemm g{H, WinT, MTOK, INW, DM}; pg8::OrderP1 S; S.init(MTOK, INW, G, bx); S.bar = bw; { pg8::Unit u3; S.next(3, u3); S.pm3 = u3.pm; S.pn3 = u3.pn; }
          pg8::EpiProj Ep{P, U2};
          pg8::gemm_phase<pg8::EpiProj, pg8::OrderP1, true, true>(lds, g, S, Ep); }
        __syncthreads();
        unsigned first_task = 0u; if (tid == 0) first_task = xb_add(&bw[EB_WORK], 1u);
        if (bx >= 64) p0_weights(a, (LAS float*)(lds + wave * 16384), P0_I_IN, P0_NITEMS, (bx - 64) * 8 + wave, (G - 64) * 8, lane);
        eb_wait(bw, (unsigned)G);
        bool have_first = true;
        LAS unsigned* tk = (LAS unsigned*)(lds + LDS_CTL) + 4;
        for (;;) {
            if (tid == 0) *tk = have_first ? first_task : xb_add(&bw[EB_WORK], 1u);
            have_first = false;
            __syncthreads();
            const unsigned t = *tk;
            __syncthreads();
            if (t >= 512u) break;
            if (t < 256u) { const int u = (int)t; const int g = u & 3, blk = (u >> 2) & 31, b = u >> 7; attn_unit(lds, P, AttnG, a.in[3], a.in[4], a.in[5], b, blk, g, tid); }
            else { const int it = (int)(t - 256u) * 8 + wave; const int c = it & (SSM_NCH - 1), g = (it / SSM_NCH) & 63, b = it / (SSM_NCH * 64); ssm_item<false>(lds + wave * SW_BYTES, a, U2, E, Yg, b, g, c, lane); __syncthreads(); }
        }
    } else {
    if (IN(1)) { pg8::Gemm g{H, WinT, MTOK, INW, DM}; pg8::StaticOrder S; S.init(MTOK, INW, G, bx); pg8::EpiProj Ep{P, U2};
        pg8::gemm_phase<pg8::EpiProj, pg8::StaticOrder, true, true>(lds, g, S, Ep);
        { const int n5 = (MTOK / 256) * (INW / 256) - 4 * G;
          if (n5 > 0 && n5 < G && G * 4 < (MTOK / 256) * (INW / 256)) { if (bx >= n5) { __syncthreads(); p0_weights(a, (LAS float*)(lds + wave * 16384), P0_I_IN, P0_NITEMS, (bx - n5) * 8 + wave, (G - n5) * 8, lane); } }
          else { __syncthreads(); p0_weights(a, (LAS float*)(lds + wave * 16384), P0_I_IN, P0_NITEMS, bx * 8 + wave, G * 8, lane); } }
    }
    SEAM(1);
    if (IN(2)) {
        for (int u = bx; u < 256; u += G) { const int g = u & 3, blk = (u >> 2) & 31, b = u >> 7; attn_unit(lds, P, AttnG, a.in[3], a.in[4], a.in[5], b, blk, g, tid); }
        const int gw = bx * 8 + wave, NGW = G * 8;
        for (int it = gw; it < SSM_ITEMS; it += NGW) { const int c = it & (SSM_NCH - 1), g = (it / SSM_NCH) & 63, b = it / (SSM_NCH * 64); ssm_item<false>(lds + wave * SW_BYTES, a, U2, E, Yg, b, g, c, lane); }
        __syncthreads();
    }
    }
    SEAM(2);
    if (IN(3)) {
        const int gw = bx * 8 + wave, NGW = G * 8;
        for (int it = gw; it < SSM_ITEMS; it += NGW) { const int c = it & (SSM_NCH - 1), g = (it / SSM_NCH) & 63, b = it / (SSM_NCH * 64); ssm_item<true>(lds + wave * SW_BYTES, a, U2, E, Yg, b, g, c, lane); }
        __syncthreads();
    }
    SEAM(3);
    const bool split45 = (lo == 0 && hi == 7 && G == 256);
    if (IN(4)) { pg8::Gemm g{Yg, WgluT, MTOK, DM, 1024}; pg8::StaticOrder S; S.init(MTOK, DM, G, bx); pg8::EpiGlu Ep{P, T, a.in[16]};
        pg8::gemm_phase<pg8::EpiGlu, pg8::StaticOrder, true, true>(lds, g, S, Ep);
        if (split45 && tid == 0) { __builtin_amdgcn_fence(__ATOMIC_RELEASE, "agent"); asm volatile("s_waitcnt vmcnt(0)" ::: "memory"); (void)xb_add(&((unsigned*)(ws + WS_BAR))[EB_CNT2], 1u); } }
    if (!split45) SEAM(4);
    if (IN(5)) { pg8::Gemm g{AttnG, WattnT, MTOK, DM, 1024, T, WssmT}; pg8::OrderDual S; S.init(MTOK, DM, G, bx); S.bar = (unsigned*)(ws + WS_BAR); S.want = split45 ? (unsigned)G : 0u; pg8::EpiDual Ep{P, Mg};
        pg8::gemm_phase<pg8::EpiDual, pg8::OrderDual, true, true>(lds, g, S, Ep); }
    SEAM(5);
    if (IN(6)) { pg8::Gemm g{Mg, WoutT, MTOK, DM, DM}; pg8::StaticOrder S; S.init(MTOK, DM, G, bx); pg8::EpiOut Ep{a.in[0], a.out};
        pg8::gemm_phase<pg8::EpiOut, pg8::StaticOrder, true, true>(lds, g, S, Ep); }
#undef IN
#undef SEAM
}

extern "C" void kernel_launch(void* const* d_in, const int* in_sizes, int n_in, void* d_out, int out_size, void* d_ws, size_t ws_size, hipStream_t stream) {
    static int grid = 0;
    if (grid == 0) {
        if (n_in != 19 || out_size != MTOK * DM || ws_size < WS_END) { fprintf(stderr, "kernel_launch: unexpected shapes (n_in %d out %d ws %zu)\n", n_in, out_size, ws_size); grid = -1; return; }
        int dev = 0, cus = 0, per_cu = 0;
        (void)hipGetDevice(&dev); (void)hipDeviceGetAttribute(&cus, hipDeviceAttributeMultiprocessorCount, dev);
        (void)hipFuncSetAttribute((const void*)fwd, hipFuncAttributeMaxDynamicSharedMemorySize, LDS_BYTES);
        (void)hipOccupancyMaxActiveBlocksPerMultiprocessor(&per_cu, (const void*)fwd, 512, LDS_BYTES);
        if (per_cu < 1) per_cu = 1;
        grid = cus * per_cu;
        (void)hipGetLastError();
    }
    if (grid < 0) return;
    if (MK_N_LAUNCHES == 1) (void)hipMemsetAsync((unsigned char*)d_ws + WS_BAR, 0, WS_BAR_BYTES, stream);
    Args a{};
    for (int i = 0; i < 19; ++i) a.in[i] = (const float*)d_in[i];
    a.out = (float*)d_out; a.ws = (unsigned char*)d_ws;
#if MK_N_LAUNCHES == 1
    a.ph_lo = 0; a.ph_hi = 7;
    void* args[] = {&a};
    hipError_t e = hipLaunchCooperativeKernel((const void*)fwd, dim3(grid), dim3(512), args, LDS_BYTES, stream);
    if (e != hipSuccess) fprintf(stderr, "cooperative launch failed: %s (grid %d)\n", hipGetErrorString(e), grid);
#else
    for (int ph = 0; ph < 7; ++ph) { a.ph_lo = ph; a.ph_hi = ph + 1; hipLaunchKernelGGL(fwd, dim3(grid), dim3(512), LDS_BYTES, stream, a); }
#endif
}
```

```cpp
#include <hip/hip_runtime.h>
#include <hip/hip_cooperative_groups.h>
#include <cstdio>
#include <cstdint>
namespace cg = cooperative_groups;
namespace pg8 {
#define PG8_LAS __attribute__((address_space(3)))
typedef unsigned short bf16_t;
typedef short bf16x8 __attribute__((ext_vector_type(8)));
typedef float f32x4 __attribute__((ext_vector_type(4)));
typedef unsigned u32x4 __attribute__((ext_vector_type(4)));
constexpr int BM = 256, BK = 64, HALF = 128, HTB = HALF * BK * 2  , STAGE_BYTES = 8 * HTB, NXCD = 8, WGM = 8;

__host__ __device__ __forceinline__ int lds_byte(int r, int c) { const int st = (r >> 4) * 2 + (c >> 5), rr = r & 15, cc = c & 31, ob = rr * 64 + cc * 2; return st * 1024 + (ob ^ (((ob >> 9) & 1) << 5)); }
__host__ __device__ __forceinline__ void stage_rc(int b, int& R, int& C) { const int st = b / 1024, sb = b % 1024, swz = sb ^ (((sb >> 9) & 1) << 5); R = (st >> 1) * 16 + swz / 64; C = (st & 1) * 32 + (swz % 64) / 2; }
__host__ __device__ __forceinline__ int perm32(int rho) { const int n = rho >> 4, i = rho & 15; return 8 * (i >> 2) + 4 * n + (i & 3); }

struct Unit { int pm, pn, w; };
struct Gemm { const bf16_t* A; const bf16_t* Bt; int M, N, K; const bf16_t* A2; const bf16_t* Bt2; };

struct StaticOrder {
    int nM, nN, nwg, G, c;
    __host__ __device__ void init(int M, int N, int G_, int c_) { nM = M / BM; nN = N / BM; nwg = nM * nN; G = G_; c = c_; }
    __host__ __device__ bool next(int i, Unit& u) const {
        const long L = (long)i * G + c; if (L >= nwg) return false;
        int wgid = (int)L; { const int q = nwg / NXCD, r = nwg % NXCD, xcd = wgid % NXCD, off = wgid / NXCD; wgid = (xcd < r ? xcd * (q + 1) : r * (q + 1) + (xcd - r) * q) + off; }
        const int nig = WGM * nN, gid = wgid / nig, fm = gid * WGM, gsz = (nM - fm) < WGM ? (nM - fm) : WGM;
        u.pm = fm + ((wgid % nig) % gsz); u.pn = (wgid % nig) / gsz; u.w = 0; return true;
    }
    __device__ __forceinline__ void a_ready(const Unit&) const {}
    __device__ __forceinline__ void done(const Unit&) const {}
};

__device__ __forceinline__ unsigned cvt_pk_bf16(float lo, float hi) { unsigned r; asm volatile("v_cvt_pk_bf16_f32 %0, %1, %2" : "=v"(r) : "v"(lo), "v"(hi)); return r; }
template <class Epi, class Sched, bool ALIGN_EPI = false, bool SP2 = false>
__device__ __forceinline__ void gemm_phase(PG8_LAS unsigned char* lds, const Gemm g, const Sched& S, const Epi& E) {
    const int tid = threadIdx.x, wid = __builtin_amdgcn_readfirstlane(tid >> 6), lane = tid & 63, wr = wid >> 2, wc = wid & 3, fr = lane & 15, fq = lane >> 4;
    const int K = g.K, nt = K / BK;
    unsigned voffA[2], voffB[2];
#pragma unroll
    for (int i = 0; i < 2; ++i) { int R, C; stage_rc(tid * 16 + i * 8192, R, C); const int Rb = Epi::PERM ? ((R & ~31) + perm32(R & 31)) : R;
        voffA[i] = (unsigned)(R * K + C) * 2u; voffB[i] = (unsigned)(Rb * K + C) * 2u; }
    const size_t kstep = (size_t)(BK * 2);
    const size_t hstep = (size_t)HALF * K * 2;
    const size_t tstep = 2 * hstep;
    const unsigned ldsw = (unsigned)wid * 1024u;
    const int aoff = lds_byte(wr * 64 + fr, fq * 8), boff = lds_byte(wc * 32 + fr, fq * 8);
#define PG8_SA(b, h) (((b) * 2 + (h)) * HTB)
#define PG8_SB(b, h) ((4 + (b) * 2 + (h)) * HTB)
#define PG8_STAGE(bufoff, gbase, voff) do { _Pragma("unroll") for (int _i = 0; _i < 2; ++_i) \
        __builtin_amdgcn_global_load_lds((const unsigned*)((const char*)(gbase) + (voff)[_i]), (PG8_LAS unsigned*)(lds + (bufoff) + ldsw + _i * 8192), 16, 0, 0); } while (0)
#define PG8_LDA(dst, b, h) do { _Pragma("unroll") for (int m = 0; m < 4; ++m) _Pragma("unroll") for (int k = 0; k < 2; ++k) dst[m][k] = *(const PG8_LAS bf16x8*)(lds + PG8_SA(b, h) + aoff + m * 2048 + k * 1024); } while (0)
#define PG8_LDB(dst, b, h) do { _Pragma("unroll") for (int n = 0; n < 2; ++n) _Pragma("unroll") for (int k = 0; k < 2; ++k) dst[n][k] = *(const PG8_LAS bf16x8*)(lds + PG8_SB(b, h) + boff + n * 2048 + k * 1024); } while (0)
#define PG8_MMA(ai, bj, At, Bt) do { __builtin_amdgcn_s_setprio(1); _Pragma("unroll") for (int m = 0; m < 4; ++m) _Pragma("unroll") for (int n = 0; n < 2; ++n) _Pragma("unroll") for (int k = 0; k < 2; ++k) \
        acc[ai][bj][m][n] = __builtin_amdgcn_mfma_f32_16x16x32_bf16(Bt[n][k], At[m][k], acc[ai][bj][m][n], 0, 0, 0); __builtin_amdgcn_s_setprio(0); } while (0)
#define PG8_WAIT_V(n) asm volatile("s_waitcnt vmcnt(" #n ")" ::: "memory")
#define PG8_WAIT_L(n) asm volatile("s_waitcnt lgkmcnt(" #n ")" ::: "memory")
#define PG8_BAR __builtin_amdgcn_s_barrier()
#define PG8_SCHED __builtin_amdgcn_sched_barrier(0)
    Unit cur, nxt; int ui = 0;
    if (!S.next(0, cur)) return;
    f32x4 acc[2][2][4][2];
#pragma unroll
    for (int a = 0; a < 2; ++a)
#pragma unroll
        for (int b = 0; b < 2; ++b)
#pragma unroll
            for (int m = 0; m < 4; ++m)
#pragma unroll
                for (int n = 0; n < 2; ++n) acc[a][b][m][n] = (f32x4){0.f, 0.f, 0.f, 0.f};
    bf16x8 At[4][2], B0[2][2], B1[2][2];
    const char* cA = (const char*)((Epi::DUAL && cur.w) ? g.A2 : g.A) + (size_t)cur.pm * tstep; const char* cB = (const char*)((Epi::DUAL && cur.w) ? g.Bt2 : g.Bt) + (size_t)cur.pn * tstep;
    S.a_ready(cur);
    if constexpr (SP2) {
        PG8_STAGE(PG8_SB(0, 0), cB, voffB); PG8_STAGE(PG8_SB(0, 1), cB + hstep, voffB); PG8_STAGE(PG8_SA(0, 0), cA, voffA); PG8_STAGE(PG8_SA(0, 1), cA + hstep, voffA);
        if (wr == 1) PG8_BAR;
        PG8_WAIT_V(2); PG8_BAR;
        PG8_STAGE(PG8_SB(1, 0), cB + kstep, voffB); PG8_STAGE(PG8_SA(1, 0), cA + kstep, voffA); PG8_STAGE(PG8_SB(1, 1), cB + hstep + kstep, voffB);
        PG8_WAIT_V(6); PG8_BAR;
    } else {
        PG8_STAGE(PG8_SB(0, 0), cB, voffB); PG8_STAGE(PG8_SA(0, 0), cA, voffA); PG8_STAGE(PG8_SB(0, 1), cB + hstep, voffB); PG8_STAGE(PG8_SA(0, 1), cA + hstep, voffA);
        if (wr == 1) PG8_BAR;
        PG8_WAIT_V(4); PG8_BAR;
        PG8_STAGE(PG8_SB(1, 0), cB + kstep, voffB); PG8_STAGE(PG8_SA(1, 0), cA + kstep, voffA); PG8_STAGE(PG8_SB(1, 1), cB + hstep + kstep, voffB);
        PG8_WAIT_V(6); PG8_BAR;
    }
    for (;;) {
        const bool has_next = S.next(ui + 1, nxt);
        const char* nA = has_next ? (const char*)((Epi::DUAL && nxt.w) ? g.A2 : g.A) + (size_t)nxt.pm * tstep : cA; const char* nB = has_next ? (const char*)((Epi::DUAL && nxt.w) ? g.Bt2 : g.Bt) + (size_t)nxt.pn * tstep : cB;
        for (int t = 0; t < nt; t += 2) {
            const bool last = (t == nt - 2);
            const char* a1 = cA + (size_t)(t + 1) * kstep;
            const char* a2 = last ? nA : cA + (size_t)(t + 2) * kstep; const char* b2 = last ? nB : cB + (size_t)(t + 2) * kstep;
            const char* a3 = a2 + kstep; const char* b3 = b2 + kstep;
            if (last && has_next) S.a_ready(nxt);
            if constexpr (SP2) {
            PG8_LDB(B0, 0, 0); PG8_LDB(B1, 0, 1); PG8_SCHED; PG8_LDA(At, 0, 0); PG8_STAGE(PG8_SA(1, 1), a1 + hstep, voffA);
            PG8_WAIT_V(8); PG8_WAIT_L(0); PG8_BAR; PG8_MMA(0, 0, At, B0); PG8_MMA(0, 1, At, B1); PG8_BAR; PG8_SCHED;
            PG8_LDA(At, 0, 1); PG8_STAGE(PG8_SB(0, 0), b2, voffB); PG8_STAGE(PG8_SB(0, 1), b2 + hstep, voffB); PG8_STAGE(PG8_SA(0, 0), a2, voffA);
            PG8_WAIT_V(8); PG8_WAIT_L(0); PG8_BAR; PG8_MMA(1, 0, At, B0); PG8_MMA(1, 1, At, B1); PG8_BAR; PG8_SCHED;
            PG8_LDB(B0, 1, 0); PG8_LDB(B1, 1, 1); PG8_SCHED; PG8_LDA(At, 1, 0); PG8_STAGE(PG8_SA(0, 1), a2 + hstep, voffA);
            PG8_WAIT_V(8); PG8_WAIT_L(0); PG8_BAR; PG8_MMA(0, 0, At, B0); PG8_MMA(0, 1, At, B1); PG8_BAR; PG8_SCHED;
            PG8_LDA(At, 1, 1); PG8_STAGE(PG8_SB(1, 0), b3, voffB); PG8_STAGE(PG8_SB(1, 1), b3 + hstep, voffB); PG8_STAGE(PG8_SA(1, 0), a3, voffA);
            PG8_WAIT_V(8); PG8_WAIT_L(0); PG8_BAR; PG8_MMA(1, 0, At, B0); PG8_MMA(1, 1, At, B1); PG8_BAR; PG8_SCHED;
            } else {
            PG8_LDB(B0, 0, 0); PG8_SCHED; PG8_LDA(At, 0, 0); PG8_STAGE(PG8_SA(1, 1), a1 + hstep, voffA);
            PG8_WAIT_L(8); PG8_BAR; PG8_WAIT_L(0); PG8_MMA(0, 0, At, B0); PG8_BAR; PG8_SCHED;
            PG8_LDB(B1, 0, 1); PG8_STAGE(PG8_SB(0, 0), b2, voffB);
            PG8_BAR; PG8_WAIT_L(0); PG8_MMA(0, 1, At, B1); PG8_BAR;
            PG8_LDA(At, 0, 1); PG8_STAGE(PG8_SA(0, 0), a2, voffA);
            PG8_BAR; PG8_WAIT_L(0); PG8_MMA(1, 0, At, B0); PG8_BAR; PG8_SCHED;
            PG8_STAGE(PG8_SB(0, 1), b2 + hstep, voffB);
            PG8_WAIT_V(6); PG8_BAR; PG8_MMA(1, 1, At, B1); PG8_BAR;
            PG8_LDB(B0, 1, 0); PG8_SCHED; PG8_LDA(At, 1, 0); PG8_STAGE(PG8_SA(0, 1), a2 + hstep, voffA);
            PG8_WAIT_L(8); PG8_BAR; PG8_WAIT_L(0); PG8_MMA(0, 0, At, B0); PG8_BAR; PG8_SCHED;
            PG8_LDB(B1, 1, 1); PG8_STAGE(PG8_SB(1, 0), b3, voffB);
            PG8_BAR; PG8_WAIT_L(0); PG8_MMA(0, 1, At, B1); PG8_BAR;
            PG8_LDA(At, 1, 1); PG8_STAGE(PG8_SA(1, 0), a3, voffA);
            PG8_BAR; PG8_WAIT_L(0); PG8_MMA(1, 0, At, B0); PG8_BAR; PG8_SCHED;
            PG8_STAGE(PG8_SB(1, 1), b3 + hstep, voffB);
            PG8_WAIT_V(6); PG8_BAR; PG8_MMA(1, 1, At, B1); PG8_BAR;
            }
        }
        if constexpr (ALIGN_EPI) { if (wr == 0) PG8_BAR; }
        if constexpr (!Epi::AFTER_DRAIN) { E(acc, cur, wr, wc, fr, fq); S.done(cur); }
        if (!has_next) break;
        if (!Epi::DUAL || cur.w)
#pragma unroll
        for (int a = 0; a < 2; ++a)
#pragma unroll
            for (int b = 0; b < 2; ++b)
#pragma unroll
                for (int m = 0; m < 4; ++m)
#pragma unroll
                    for (int n = 0; n < 2; ++n) acc[a][b][m][n] = (f32x4){0.f, 0.f, 0.f, 0.f};
        cur = nxt; cA = nA; cB = nB; ++ui;
        if constexpr (ALIGN_EPI) { if (wr == 1) PG8_BAR; }
    }
    PG8_WAIT_V(0);
    if constexpr (!ALIGN_EPI) { if (wr == 0) PG8_BAR; }
    PG8_BAR;
    if constexpr (Epi::AFTER_DRAIN) { E.fused(acc, cur, wr, wc, fr, fq, lds, wid, lane); S.done(cur); }
#undef PG8_SA
#undef PG8_SB
#undef PG8_STAGE
#undef PG8_LDA
#undef PG8_LDB
#undef PG8_MMA
#undef PG8_WAIT_V
#undef PG8_WAIT_L
#undef PG8_BAR
#undef PG8_SCHED
}
}

#ifndef MK_N_LAUNCHES
#define MK_N_LAUNCHES 1
#endif
constexpr int DM = 2048, SEQ = 4096, MTOK = 8192, INW = 8704;
constexpr int C_Q = 0, C_K = 1024, C_V = 1280, C_AG = 1536, C_U = 2560, C_Z = 3584, C_GA = 4608, C_GS = 6656;
constexpr float LOG2E = 1.4426950408889634f;
constexpr size_t MiB = 1u << 20;
constexpr size_t WS_WIN = 0, WS_WATTN = 34 * MiB, WS_WGLU = 38 * MiB, WS_WSSM = 42 * MiB, WS_WOUT = 46 * MiB;
constexpr size_t WS_H = 54 * MiB, WS_ATTNG = 224 * MiB  , WS_YG = 70 * MiB, WS_P = 86 * MiB, WS_MG = 0, WS_BAR = 222 * MiB, WS_BAR_BYTES = 16384, WS_TBQ = 222 * MiB + 65536, WS_TCC = WS_TBQ + 524288, WS_TAB = WS_TCC + 524288, WS_END = 240 * MiB;
constexpr int LDS_CTL = 147200;
constexpr size_t OUT_T = 0, OUT_E = 16 * MiB, OUT_U2 = 32 * MiB;
constexpr int LDS_BYTES = 147456;

#define LAS __attribute__((address_space(3)))
typedef unsigned short bf16_t;
typedef unsigned u32x4 __attribute__((ext_vector_type(4)));
typedef unsigned u32x2 __attribute__((ext_vector_type(2)));
typedef float f32x4 __attribute__((ext_vector_type(4)));
typedef short bf16x8 __attribute__((ext_vector_type(8)));
typedef float f32x2 __attribute__((ext_vector_type(2)));

__device__ __forceinline__ unsigned f2bf(float f) { unsigned u = __builtin_bit_cast(unsigned, f); return (u + 0x7fffu + ((u >> 16) & 1u)) >> 16; }
__device__ __forceinline__ float bf2f(unsigned b) { return __builtin_bit_cast(float, b << 16); }
__device__ __forceinline__ float bflo(unsigned w) { return __builtin_bit_cast(float, w << 16); }
__device__ __forceinline__ float bfhi(unsigned w) { return __builtin_bit_cast(float, w & 0xffff0000u); }
__device__ __forceinline__ unsigned pk2(float lo, float hi) { return pg8::cvt_pk_bf16(lo, hi); }
typedef __bf16 bf16x2_t __attribute__((ext_vector_type(2)));
__device__ __forceinline__ unsigned pk2c(float lo, float hi) { const f32x2 v = {lo, hi}; const bf16x2_t b = __builtin_convertvector(v, bf16x2_t); return __builtin_bit_cast(unsigned, b); }
__device__ __forceinline__ float fsigmoid(float x) { return __builtin_amdgcn_rcpf(1.f + __expf(-x)); }
__device__ __forceinline__ float fsilu(float x) { return x * fsigmoid(x); }
__device__ __forceinline__ float fgelu_tanh(float x) { const float z = 0.7978845608028654f * (x + 0.044715f * x * x * x); return x * fsigmoid(2.f * z); }

namespace pg8 {
struct EpiProj {
    static constexpr bool PERM = true, AFTER_DRAIN = false, DUAL = false;
    bf16_t* O; bf16_t* U2;
    __device__ __forceinline__ void operator()(const f32x4 (&acc)[2][2][4][2], const Unit& u, int wr, int wc, int fr, int fq) const {
        const int pn = u.pn;
        if (pn >= 10 && pn < 14) {
            const int row0 = u.pm * BM + wr * 64 + fr, cu0 = (pn - 10) * BM + wc * 32 + 8 * fq;
#pragma unroll
            for (int ai = 0; ai < 2; ++ai)
#pragma unroll
                for (int m = 0; m < 4; ++m) { const int row = row0 + ai * HALF + m * 16; const int bb = row >> 12, t = row & 4095;
#pragma unroll
                    for (int bj = 0; bj < 2; ++bj) { const f32x4 v0 = acc[ai][bj][m][0], v1 = acc[ai][bj][m][1]; const int cu = cu0 + bj * HALF;
                        u32x4 w; w.x = cvt_pk_bf16(v0[0], v0[1]); w.y = cvt_pk_bf16(v0[2], v0[3]); w.z = cvt_pk_bf16(v1[0], v1[1]); w.w = cvt_pk_bf16(v1[2], v1[3]);
                        *(u32x4*)(U2 + ((size_t)(bb * 64 + (cu >> 4)) * 4096 + t) * 16 + (cu & 15)) = w; } }
            return;
        }
        const int act = (pn >= 18) ? 2 : (((pn >= 6 && pn < 10) || (pn >= 14 && pn < 18)) ? 1 : 0);
        const int row0 = u.pm * BM + wr * 64 + fr, col0 = pn * BM + wc * 32 + 8 * fq;
#pragma unroll
        for (int ai = 0; ai < 2; ++ai)
#pragma unroll
            for (int m = 0; m < 4; ++m) { bf16_t* rowp = O + (size_t)(row0 + ai * HALF + m * 16) * INW + col0;
#pragma unroll
                for (int bj = 0; bj < 2; ++bj) { f32x4 v0 = acc[ai][bj][m][0], v1 = acc[ai][bj][m][1];
                    if (act == 1) {
#pragma unroll
                        for (int i = 0; i < 4; ++i) { v0[i] = fsilu(v0[i]); v1[i] = fsilu(v1[i]); } }
                    else if (act == 2) {
#pragma unroll
                        for (int i = 0; i < 4; ++i) { v0[i] = fsigmoid(v0[i]); v1[i] = fsigmoid(v1[i]); } }
                    u32x4 w; w.x = cvt_pk_bf16(v0[0], v0[1]); w.y = cvt_pk_bf16(v0[2], v0[3]); w.z = cvt_pk_bf16(v1[0], v1[1]); w.w = cvt_pk_bf16(v1[2], v1[3]);
                    *(u32x4*)(rowp + bj * HALF) = w; } }
    }
};
struct EpiYa {
    static constexpr bool PERM = true, AFTER_DRAIN = false, DUAL = false;
    const bf16_t* __restrict__ P; bf16_t* __restrict__ Mg;
    __device__ __forceinline__ void operator()(const f32x4 (&acc)[2][2][4][2], const Unit& u, int wr, int wc, int fr, int fq) const {
        const int row0 = u.pm * BM + wr * 64 + fr, col0 = u.pn * BM + wc * 32 + 8 * fq;
        u32x4 g[2][4][2];
#pragma unroll
        for (int ai = 0; ai < 2; ++ai)
#pragma unroll
            for (int m = 0; m < 4; ++m)
#pragma unroll
                for (int bj = 0; bj < 2; ++bj) g[ai][m][bj] = *(const u32x4*)(P + (size_t)(row0 + ai * HALF + m * 16) * INW + C_GA + col0 + bj * HALF);
#pragma unroll
        for (int ai = 0; ai < 2; ++ai)
#pragma unroll
            for (int m = 0; m < 4; ++m) { const size_t r = (size_t)(row0 + ai * HALF + m * 16);
#pragma unroll
                for (int bj = 0; bj < 2; ++bj) { const f32x4 v0 = acc[ai][bj][m][0], v1 = acc[ai][bj][m][1]; const u32x4 gg = g[ai][m][bj];
                    u32x4 w; w.x = cvt_pk_bf16(v0[0] * bflo(gg.x), v0[1] * bfhi(gg.x)); w.y = cvt_pk_bf16(v0[2] * bflo(gg.y), v0[3] * bfhi(gg.y));
                    w.z = cvt_pk_bf16(v1[0] * bflo(gg.z), v1[1] * bfhi(gg.z)); w.w = cvt_pk_bf16(v1[2] * bflo(gg.w), v1[3] * bfhi(gg.w));
                    *(u32x4*)(Mg + r * DM + col0 + bj * HALF) = w; } }
    }
};
struct EpiGlu {
    static constexpr bool PERM = true, AFTER_DRAIN = false, DUAL = false;
    const bf16_t* __restrict__ P; bf16_t* __restrict__ T; const float* __restrict__ bias;
    __device__ __forceinline__ void operator()(const f32x4 (&acc)[2][2][4][2], const Unit& u, int wr, int wc, int fr, int fq) const {
        const int row0 = u.pm * BM + wr * 64 + fr, col0 = u.pn * HALF + wc * 32 + 8 * fq;
        u32x4 zz[2][4];
#pragma unroll
        for (int ai = 0; ai < 2; ++ai)
#pragma unroll
            for (int m = 0; m < 4; ++m) zz[ai][m] = *(const u32x4*)(P + (size_t)(row0 + ai * HALF + m * 16) * INW + C_Z + col0);
        const f32x4 ba0 = *(const f32x4*)(bias + col0), ba1 = *(const f32x4*)(bias + col0 + 4);
        const f32x4 bb0 = *(const f32x4*)(bias + 1024 + col0), bb1 = *(const f32x4*)(bias + 1024 + col0 + 4);
#pragma unroll
        for (int ai = 0; ai < 2; ++ai)
#pragma unroll
            for (int m = 0; m < 4; ++m) { const size_t r = (size_t)(row0 + ai * HALF + m * 16);
                const f32x4 a0 = acc[ai][0][m][0] + ba0, a1 = acc[ai][0][m][1] + ba1, b0 = acc[ai][1][m][0] + bb0, b1 = acc[ai][1][m][1] + bb1;
                const u32x4 z = zz[ai][m];
                u32x4 w;
                w.x = cvt_pk_bf16(a0[0] * fsigmoid(b0[0]) * bflo(z.x), a0[1] * fsigmoid(b0[1]) * bfhi(z.x));
                w.y = cvt_pk_bf16(a0[2] * fsigmoid(b0[2]) * bflo(z.y), a0[3] * fsigmoid(b0[3]) * bfhi(z.y));
                w.z = cvt_pk_bf16(a1[0] * fsigmoid(b1[0]) * bflo(z.z), a1[1] * fsigmoid(b1[1]) * bfhi(z.z));
                w.w = cvt_pk_bf16(a1[2] * fsigmoid(b1[2]) * bflo(z.w), a1[3] * fsigmoid(b1[3]) * bfhi(z.w));
                *(u32x4*)(T + r * 1024 + col0) = w; }
    }
};
struct EpiYs {
    static constexpr bool PERM = true, AFTER_DRAIN = false, DUAL = false;
    const bf16_t* __restrict__ P; bf16_t* Mg;
    __device__ __forceinline__ void operator()(const f32x4 (&acc)[2][2][4][2], const Unit& u, int wr, int wc, int fr, int fq) const {
        const int row0 = u.pm * BM + wr * 64 + fr, col0 = u.pn * BM + wc * 32 + 8 * fq;
#pragma unroll
        for (int ai = 0; ai < 2; ++ai) {
            u32x4 g[4][2], p[4][2];
#pragma unroll
            for (int m = 0; m < 4; ++m)
#pragma unroll
                for (int bj = 0; bj < 2; ++bj) { const size_t r = (size_t)(row0 + ai * HALF + m * 16);
                    g[m][bj] = *(const u32x4*)(P + r * INW + C_GS + col0 + bj * HALF); p[m][bj] = *(const u32x4*)(Mg + r * DM + col0 + bj * HALF); }
            asm volatile("" ::: "memory");
#pragma unroll
            for (int m = 0; m < 4; ++m) { const size_t r = (size_t)(row0 + ai * HALF + m * 16);
#pragma unroll
                for (int bj = 0; bj < 2; ++bj) { const f32x4 v0 = acc[ai][bj][m][0], v1 = acc[ai][bj][m][1]; const u32x4 gg = g[m][bj], pp = p[m][bj];
                    u32x4 w; w.x = cvt_pk_bf16(bflo(pp.x) + v0[0] * bflo(gg.x), bfhi(pp.x) + v0[1] * bfhi(gg.x)); w.y = cvt_pk_bf16(bflo(pp.y) + v0[2] * bflo(gg.y), bfhi(pp.y) + v0[3] * bfhi(gg.y));
                    w.z = cvt_pk_bf16(bflo(pp.z) + v1[0] * bflo(gg.z), bfhi(pp.z) + v1[1] * bfhi(gg.z)); w.w = cvt_pk_bf16(bflo(pp.w) + v1[2] * bflo(gg.w), bfhi(pp.w) + v1[3] * bfhi(gg.w));
                    *(u32x4*)(Mg + r * DM + col0 + bj * HALF) = w; } }
            asm volatile("" ::: "memory");
        }
    }
};
struct EpiDual {
    static constexpr bool PERM = true, AFTER_DRAIN = false, DUAL = true;
    const bf16_t* __restrict__ P; bf16_t* __restrict__ Mg;
    __device__ __forceinline__ void operator()(f32x4 (&acc)[2][2][4][2], const Unit& u, int wr, int wc, int fr, int fq) const {
        const int row0 = u.pm * BM + wr * 64 + fr, col0 = u.pn * BM + wc * 32 + 8 * fq;
        if (u.w == 0) {
#pragma unroll
            for (int ai = 0; ai < 2; ++ai) {
                u32x4 ga[4][2], gs[4][2];
#pragma unroll
                for (int m = 0; m < 4; ++m)
#pragma unroll
                    for (int bj = 0; bj < 2; ++bj) { const size_t r = (size_t)(row0 + ai * HALF + m * 16);
                        ga[m][bj] = *(const u32x4*)(P + r * INW + C_GA + col0 + bj * HALF); gs[m][bj] = *(const u32x4*)(P + r * INW + C_GS + col0 + bj * HALF); }
#pragma unroll
                for (int m = 0; m < 4; ++m)
#pragma unroll
                    for (int bj = 0; bj < 2; ++bj) { const u32x4 a_ = ga[m][bj], s_ = gs[m][bj]; f32x4& v0 = acc[ai][bj][m][0]; f32x4& v1 = acc[ai][bj][m][1];
                        v0[0] *= bflo(a_.x) * __builtin_amdgcn_rcpf(1e-30f + bflo(s_.x)); v0[1] *= bfhi(a_.x) * __builtin_amdgcn_rcpf(1e-30f + bfhi(s_.x)); v0[2] *= bflo(a_.y) * __builtin_amdgcn_rcpf(1e-30f + bflo(s_.y)); v0[3] *= bfhi(a_.y) * __builtin_amdgcn_rcpf(1e-30f + bfhi(s_.y));
                        v1[0] *= bflo(a_.z) * __builtin_amdgcn_rcpf(1e-30f + bflo(s_.z)); v1[1] *= bfhi(a_.z) * __builtin_amdgcn_rcpf(1e-30f + bfhi(s_.z)); v1[2] *= bflo(a_.w) * __builtin_amdgcn_rcpf(1e-30f + bflo(s_.w)); v1[3] *= bfhi(a_.w) * __builtin_amdgcn_rcpf(1e-30f + bfhi(s_.w)); }
            }
        } else {
#pragma unroll
            for (int ai = 0; ai < 2; ++ai) {
                u32x4 gs[4][2];
#pragma unroll
                for (int m = 0; m < 4; ++m)
#pragma unroll
                    for (int bj = 0; bj < 2; ++bj) gs[m][bj] = *(const u32x4*)(P + (size_t)(row0 + ai * HALF + m * 16) * INW + C_GS + col0 + bj * HALF);
#pragma unroll
                for (int m = 0; m < 4; ++m) { const size_t r = (size_t)(row0 + ai * HALF + m * 16);
#pragma unroll
                    for (int bj = 0; bj < 2; ++bj) { const f32x4 v0 = acc[ai][bj][m][0], v1 = acc[ai][bj][m][1]; const u32x4 gg = gs[m][bj];
                        u32x4 w; w.x = cvt_pk_bf16(v0[0] * bflo(gg.x), v0[1] * bfhi(gg.x)); w.y = cvt_pk_bf16(v0[2] * bflo(gg.y), v0[3] * bfhi(gg.y));
                        w.z = cvt_pk_bf16(v1[0] * bflo(gg.z), v1[1] * bfhi(gg.z)); w.w = cvt_pk_bf16(v1[2] * bflo(gg.w), v1[3] * bfhi(gg.w));
                        *(u32x4*)(Mg + r * DM + col0 + bj * HALF) = w; } }
            }
        }
    }
};
struct EpiOut {
    static constexpr bool PERM = true, AFTER_DRAIN = false, DUAL = false;
    const float* __restrict__ X; float* __restrict__ O;
    __device__ __forceinline__ void operator()(const f32x4 (&acc)[2][2][4][2], const Unit& u, int wr, int wc, int fr, int fq) const {
        const int row0 = u.pm * BM + wr * 64 + fr, col0 = u.pn * BM + wc * 32 + 8 * fq;
#pragma unroll
        for (int ai = 0; ai < 2; ++ai) {
            f32x4 xv[4][2][2];
#pragma unroll
            for (int m = 0; m < 4; ++m)
#pragma unroll
                for (int bj = 0; bj < 2; ++bj) { const size_t off = (size_t)(row0 + ai * HALF + m * 16) * DM + col0 + bj * HALF;
                    xv[m][bj][0] = __builtin_nontemporal_load((const f32x4*)(X + off)); xv[m][bj][1] = __builtin_nontemporal_load((const f32x4*)(X + off + 4)); }
            asm volatile("" ::: "memory");
#pragma unroll
            for (int m = 0; m < 4; ++m)
#pragma unroll
                for (int bj = 0; bj < 2; ++bj) { const size_t off = (size_t)(row0 + ai * HALF + m * 16) * DM + col0 + bj * HALF;
                    __builtin_nontemporal_store(xv[m][bj][0] + acc[ai][bj][m][0], (f32x4*)(O + off)); __builtin_nontemporal_store(xv[m][bj][1] + acc[ai][bj][m][1], (f32x4*)(O + off + 4)); }
            asm volatile("" ::: "memory");
        }
    }
};
}

__device__ __forceinline__ float wave_sum(float v) {
#pragma unroll
    for (int o = 1; o < 64; o <<= 1) v += __shfl_xor(v, o);
    return v;
}
struct Args { const float* in[19]; float* out; unsigned char* ws; int ph_lo, ph_hi; };
constexpr int P0_I_IN = (DM / 64) * (INW / 32), P0_I_A = (1024 / 64) * (2048 / 32), P0_I_O = (2048 / 64) * (2048 / 32);
constexpr int P0_NITEMS = P0_I_IN + 3 * P0_I_A + P0_I_O;
struct P0Item { const float* W; bf16_t* WT; int K, N, k0, n0, d0; };
__device__ __forceinline__ P0Item p0_item(const Args& a, int it) {
    P0Item r; int glu = 0; unsigned char* ws = a.ws;
    if (it < P0_I_IN) { r.W = a.in[2]; r.K = DM; r.N = INW; r.WT = (bf16_t*)(ws + WS_WIN); }
    else { it -= P0_I_IN;
        if (it < P0_I_A) { r.W = a.in[6]; r.K = 1024; r.N = 2048; r.WT = (bf16_t*)(ws + WS_WATTN); }
        else { it -= P0_I_A;
            if (it < P0_I_A) { r.W = a.in[15]; r.K = 1024; r.N = 2048; r.WT = (bf16_t*)(ws + WS_WGLU); glu = 1; }
            else { it -= P0_I_A;
                if (it < P0_I_A) { r.W = a.in[17]; r.K = 1024; r.N = 2048; r.WT = (bf16_t*)(ws + WS_WSSM); }
                else { it -= P0_I_A; r.W = a.in[18]; r.K = 2048; r.N = 2048; r.WT = (bf16_t*)(ws + WS_WOUT); } } } }
    const int nblk = r.N / 32, kb = it / nblk, nb = it % nblk; r.k0 = 64 * kb; r.n0 = 32 * nb;
    r.d0 = glu ? ((r.n0 < 1024) ? (256 * (r.n0 >> 7) + (r.n0 & 127)) : (256 * ((r.n0 - 1024) >> 7) + 128 + (r.n0 & 127))) : r.n0;
    return r;
}
__device__ __forceinline__ void p0_load(const P0Item& t, f32x4 (&v)[8], int lane) {
#pragma unroll
    for (int i = 0; i < 8; ++i) v[i] = __builtin_nontemporal_load((const f32x4*)(t.W + (size_t)(t.k0 + (lane >> 3) + 8 * i) * t.N + t.n0 + 4 * (lane & 7)));
}
__device__ __forceinline__ void p0_store(const P0Item& t, const f32x4 (&v)[8], LAS float* scr, int lane) {
#pragma unroll
    for (int i = 0; i < 8; ++i) { LAS float* d = scr + ((lane >> 3) + 8 * i) * 33 + 4 * (lane & 7); d[0] = v[i].x; d[1] = v[i].y; d[2] = v[i].z; d[3] = v[i].w; }
    asm volatile("s_waitcnt lgkmcnt(0)" ::: "memory");
    const int c = lane & 7;
#pragma unroll
    for (int j = 0; j < 4; ++j) { const int n = (lane >> 3) + 8 * j; const LAS float* s = scr + (8 * c) * 33 + n;
        u32x4 o; o.x = pk2(s[0 * 33], s[1 * 33]); o.y = pk2(s[2 * 33], s[3 * 33]); o.z = pk2(s[4 * 33], s[5 * 33]); o.w = pk2(s[6 * 33], s[7 * 33]);
        *(u32x4*)(t.WT + (size_t)(t.d0 + n) * t.K + t.k0 + 8 * c) = o; }
    asm volatile("s_waitcnt lgkmcnt(0)" ::: "memory");
}
__device__ __forceinline__ void p0_weights(const Args& a, LAS float* scr, int it_lo, int it_hi, int gw, int nw, int lane) {
    int it = it_lo + gw; if (it >= it_hi) return;
    P0Item cur = p0_item(a, it); f32x4 v[8]; p0_load(cur, v, lane);
    for (;;) {
        const int itn = it + nw; const bool more = itn < it_hi;
        P0Item nxt = cur; f32x4 vn[8];
        if (more) { nxt = p0_item(a, itn); p0_load(nxt, vn, lane); }
        p0_store(cur, v, scr, lane);
        if (!more) break;
        cur = nxt; it = itn;
#pragma unroll
        for (int i = 0; i < 8; ++i) v[i] = vn[i];
    }
}
__device__ __forceinline__ void ssm_table_task(const Args& a, int task, int lane) {
    const int fr = lane & 15, fq = lane >> 4;
    const float* A_re = a.in[7]; const float* A_im = a.in[8]; const float* log_dt = a.in[9]; const float* B_re = a.in[10]; const float* B_im = a.in[11];
    const float* C_re = a.in[12]; const float* C_im = a.in[13];
    const int g = task / 13, sub = task % 13;
    if (sub < 8) {
        const int nt = sub; const int p = 8 * nt + (fr >> 1);
        const float dt = expf(log_dt[g]);
        const float ar = A_re[g * 64 + p], ai = A_im[g * 64 + p];
        const float* br = B_re + ((size_t)(g * 64 + p)) * 16 + 8 * (fq & 1); const float* bi = B_im + ((size_t)(g * 64 + p)) * 16 + 8 * (fq & 1);
        const f32x4 br0 = *(const f32x4*)br, br1 = *(const f32x4*)(br + 4), bi0 = *(const f32x4*)bi, bi1 = *(const f32x4*)(bi + 4);
        const float mag = expf(dt * ar); float sn, cs; sincosf(dt * ai, &sn, &cs);
        const float nr = mag * cs - 1.0f, ni = mag * sn, den = ar * ar + ai * ai; const float cfr = (nr * ar + ni * ai) / den, cfi = (ni * ar - nr * ai) / den;
        const float m0 = (fr & 1) ? cfi : cfr, m1 = (fr & 1) ? cfr : -cfi;
        float v[8];
#pragma unroll
        for (int i = 0; i < 4; ++i) { v[i] = m0 * br0[i] + m1 * bi0[i]; v[4 + i] = m0 * br1[i] + m1 * bi1[i]; }
        if (fq >= 2) {
#pragma unroll
            for (int i = 0; i < 8; ++i) v[i] = v[i] - bf2f(f2bf(v[i])); }
        u32x4 w_; w_.x = pk2(v[0], v[1]); w_.y = pk2(v[2], v[3]); w_.z = pk2(v[4], v[5]); w_.w = pk2(v[6], v[7]);
        ((u32x4*)(a.ws + WS_TBQ))[(g * 8 + nt) * 64 + lane] = w_;
    } else if (sub < 12) {
        const int ks = sub - 8; const size_t co = ((size_t)(g * 16 + fr)) * 64 + 16 * ks + 4 * fq;
        const f32x4 cr = *(const f32x4*)(C_re + co), ci = *(const f32x4*)(C_im + co);
        float v[8] = {cr[0], -ci[0], cr[1], -ci[1], cr[2], -ci[2], cr[3], -ci[3]}; float lo[8];
#pragma unroll
        for (int i = 0; i < 8; ++i) lo[i] = v[i] - bf2f(f2bf(v[i]));
        u32x4 wh, wl_; wh.x = pk2(v[0], v[1]); wh.y = pk2(v[2], v[3]); wh.z = pk2(v[4], v[5]); wh.w = pk2(v[6], v[7]);
        wl_.x = pk2(lo[0], lo[1]); wl_.y = pk2(lo[2], lo[3]); wl_.z = pk2(lo[4], lo[5]); wl_.w = pk2(lo[6], lo[7]);
        ((u32x4*)(a.ws + WS_TCC))[((g * 4 + ks) * 2 + 0) * 64 + lane] = wh; ((u32x4*)(a.ws + WS_TCC))[((g * 4 + ks) * 2 + 1) * 64 + lane] = wl_;
    } else {
        const float dt = expf(log_dt[g]);
        const float ar = A_re[g * 64 + lane], ai = A_im[g * 64 + lane]; const float mag = expf(dt * ar); float sn, cs; sincosf(dt * ai, &sn, &cs);
        ((f32x2*)(a.ws + WS_TAB))[g * 64 + lane] = (f32x2){mag * cs, mag * sn};
    }
}
__device__ __forceinline__ void p0_prologue(const Args& a, LAS unsigned char* lds, int wave, int lane) {
    LAS float* scr = (LAS float*)(lds + wave * 16384);
    const int gw = blockIdx.x * 8 + wave, NGW = gridDim.x * 8;
    unsigned char* ws = a.ws;
    const float* x = a.in[0]; const float* nw = a.in[1]; bf16_t* H = (bf16_t*)(ws + WS_H);
    f32x4 wv[8];
#pragma unroll
    for (int j = 0; j < 8; ++j) wv[j] = *((const f32x4*)nw + lane + 64 * j);
    int m = gw;
    f32x4 v[8];
    if (m < MTOK) {
#pragma unroll
        for (int j = 0; j < 8; ++j) v[j] = __builtin_nontemporal_load((const f32x4*)(x + (size_t)m * DM) + lane + 64 * j); }
    for (int t = gw; t < 64 * 13; t += NGW) ssm_table_task(a, t, lane);
    p0_weights(a, scr, 0, P0_I_IN, gw, NGW, lane);
    if (m >= MTOK) return;
    for (;;) {
        const int mn = m + NGW; const bool more = mn < MTOK; f32x4 vn[8];
        if (more) {
#pragma unroll
            for (int j = 0; j < 8; ++j) vn[j] = __builtin_nontemporal_load((const f32x4*)(x + (size_t)mn * DM) + lane + 64 * j); }
        float s = 0.f;
#pragma unroll
        for (int j = 0; j < 8; ++j) s += (v[j].x * v[j].x + v[j].y * v[j].y) + (v[j].z * v[j].z + v[j].w * v[j].w);
        const float rstd = rsqrtf(wave_sum(s) * (1.f / DM) + 1e-6f);
        u32x2* o8 = (u32x2*)(H + (size_t)m * DM) + lane;
#pragma unroll
        for (int j = 0; j < 8; ++j) { u32x2 o; o.x = pk2(v[j].x * rstd * wv[j].x, v[j].y * rstd * wv[j].y); o.y = pk2(v[j].z * rstd * wv[j].z, v[j].w * rstd * wv[j].w); o8[64 * j] = o; }
        if (!more) break;
        m = mn;
#pragma unroll
        for (int j = 0; j < 8; ++j) v[j] = vn[j];
    }
}

constexpr int KL_STRIDE = 144, VT_STRIDE = 528, KL_BYTES = 256 * KL_STRIDE;
__device__ __forceinline__ void attn_unit(LAS unsigned char* lds, const bf16_t* P, bf16_t* AttnG, const float* qw, const float* kw, const float* sinks, int b, int blk, int g, int tid) {
    const int lane = tid & 63, w = tid >> 6, fr = lane & 15, fq = lane >> 4;
    const long base = (long)b * SEQ + (long)blk * 128;
    LAS unsigned char* Kl = lds; LAS unsigned char* Vt = lds + KL_BYTES;
    const long tok = base + 16 * w + fr;
    u32x4 qraw[4][2]; u32x2 graw[4][4]; u32x4 kraw[4], vraw[4];
    const int c = tid & 7;
#pragma unroll
    for (int i = 0; i < 4; ++i) { int key = (tid >> 3) + 64 * i; if (blk == 0 && key < 128) key += 128;
        kraw[i] = *(const u32x4*)(P + (size_t)(base - 128 + key) * INW + C_K + g * 64 + 8 * c); }
#pragma unroll
    for (int i = 0; i < 4; ++i) { int key = lane + 64 * i; if (blk == 0 && key < 128) key += 128;
        vraw[i] = *(const u32x4*)(P + (size_t)(base - 128 + key) * INW + C_V + g * 64 + 8 * w); }
#pragma unroll
    for (int r = 0; r < 4; ++r) { const int h = 4 * g + r;
        qraw[r][0] = *(const u32x4*)(P + (size_t)tok * INW + C_Q + h * 64 + 8 * fq); qraw[r][1] = *(const u32x4*)(P + (size_t)tok * INW + C_Q + h * 64 + 32 + 8 * fq);
#pragma unroll
        for (int dt = 0; dt < 4; ++dt) graw[r][dt] = *(const u32x2*)(P + (size_t)tok * INW + C_AG + h * 64 + 16 * dt + 4 * fq); }
    const f32x4 kw0 = *(const f32x4*)(kw + 8 * c), kw1 = *(const f32x4*)(kw + 8 * c + 4);
    const f32x4 qwa0 = *(const f32x4*)(qw + 8 * fq), qwa1 = *(const f32x4*)(qw + 8 * fq + 4), qwb0 = *(const f32x4*)(qw + 32 + 8 * fq), qwb1 = *(const f32x4*)(qw + 32 + 8 * fq + 4);
    const f32x4 sk4 = *(const f32x4*)(sinks + 4 * g);
    if (blk == 0) {
#pragma unroll
        for (int i = 0; i < 2; ++i) { kraw[i] = (u32x4){0u, 0u, 0u, 0u}; vraw[i] = (u32x4){0u, 0u, 0u, 0u}; } }
    {
        const f32x4 kw0 = *(const f32x4*)(kw + 8 * c), kw1 = *(const f32x4*)(kw + 8 * c + 4);
#pragma unroll
        for (int i = 0; i < 4; ++i) { const int key = (tid >> 3) + 64 * i; const u32x4 raw = kraw[i];
            float f[8] = {bflo(raw.x), bfhi(raw.x), bflo(raw.y), bfhi(raw.y), bflo(raw.z), bfhi(raw.z), bflo(raw.w), bfhi(raw.w)};
            float ss = 0.f;
#pragma unroll
            for (int e = 0; e < 8; ++e) ss += f[e] * f[e];
            ss += __shfl_xor(ss, 1); ss += __shfl_xor(ss, 2); ss += __shfl_xor(ss, 4);
            const float rstd = rsqrtf(ss * (1.f / 64.f) + 1e-6f);
            u32x4 o; o.x = pk2(f[0] * rstd * kw0[0], f[1] * rstd * kw0[1]); o.y = pk2(f[2] * rstd * kw0[2], f[3] * rstd * kw0[3]);
            o.z = pk2(f[4] * rstd * kw1[0], f[5] * rstd * kw1[1]); o.w = pk2(f[6] * rstd * kw1[2], f[7] * rstd * kw1[3]);
            *(LAS u32x4*)(Kl + key * KL_STRIDE + c * 16) = o; }
#pragma unroll
        for (int i = 0; i < 4; ++i) { const int key = lane + 64 * i; const u32x4 raw = vraw[i];
            LAS unsigned short* vp = (LAS unsigned short*)(Vt + (8 * w) * VT_STRIDE + key * 2);
            vp[0 * (VT_STRIDE / 2)] = (unsigned short)(raw.x & 0xffffu); vp[1 * (VT_STRIDE / 2)] = (unsigned short)(raw.x >> 16);
            vp[2 * (VT_STRIDE / 2)] = (unsigned short)(raw.y & 0xffffu); vp[3 * (VT_STRIDE / 2)] = (unsigned short)(raw.y >> 16);
            vp[4 * (VT_STRIDE / 2)] = (unsigned short)(raw.z & 0xffffu); vp[5 * (VT_STRIDE / 2)] = (unsigned short)(raw.z >> 16);
            vp[6 * (VT_STRIDE / 2)] = (unsigned short)(raw.w & 0xffffu); vp[7 * (VT_STRIDE / 2)] = (unsigned short)(raw.w >> 16); }
    }
    __syncthreads();
#pragma unroll
    for (int r = 0; r < 4; ++r) {
        const int h = 4 * g + r;
        const u32x4 r0 = qraw[r][0], r1 = qraw[r][1];
        float q0[8] = {bflo(r0.x), bfhi(r0.x), bflo(r0.y), bfhi(r0.y), bflo(r0.z), bfhi(r0.z), bflo(r0.w), bfhi(r0.w)};
        float q1[8] = {bflo(r1.x), bfhi(r1.x), bflo(r1.y), bfhi(r1.y), bflo(r1.z), bfhi(r1.z), bflo(r1.w), bfhi(r1.w)};
        float ss = 0.f;
#pragma unroll
        for (int e = 0; e < 8; ++e) ss += q0[e] * q0[e] + q1[e] * q1[e];
        ss += __shfl_xor(ss, 16); ss += __shfl_xor(ss, 32);
        const float qs = rsqrtf(ss * (1.f / 64.f) + 1e-6f) * (0.125f * LOG2E);
        u32x4 qa, qb;
        qa.x = pk2(q0[0] * qs * qwa0[0], q0[1] * qs * qwa0[1]); qa.y = pk2(q0[2] * qs * qwa0[2], q0[3] * qs * qwa0[3]); qa.z = pk2(q0[4] * qs * qwa1[0], q0[5] * qs * qwa1[1]); qa.w = pk2(q0[6] * qs * qwa1[2], q0[7] * qs * qwa1[3]);
        qb.x = pk2(q1[0] * qs * qwb0[0], q1[1] * qs * qwb0[1]); qb.y = pk2(q1[2] * qs * qwb0[2], q1[3] * qs * qwb0[3]); qb.z = pk2(q1[4] * qs * qwb1[0], q1[5] * qs * qwb1[1]); qb.w = pk2(q1[6] * qs * qwb1[2], q1[7] * qs * qwb1[3]);
        const bf16x8 qf0 = __builtin_bit_cast(bf16x8, qa), qf1 = __builtin_bit_cast(bf16x8, qb);
        f32x4 s[9];
#pragma unroll
        for (int tt = 0; tt < 9; ++tt) { const LAS unsigned char* kp = Kl + (16 * (w + tt) + fr) * KL_STRIDE + 16 * fq;
            const bf16x8 a0 = *(const LAS bf16x8*)kp, a1 = *(const LAS bf16x8*)(kp + 64);
            f32x4 z = (f32x4){0.f, 0.f, 0.f, 0.f};
            z = __builtin_amdgcn_mfma_f32_16x16x32_bf16(a0, qf0, z, 0, 0, 0); s[tt] = __builtin_amdgcn_mfma_f32_16x16x32_bf16(a1, qf1, z, 0, 0, 0); }
        const float sink2 = sk4[r] * LOG2E; float mx = sink2;
#pragma unroll
        for (int tt = 0; tt < 9; ++tt)
#pragma unroll
            for (int j = 0; j < 4; ++j) { const int diff = 128 + fr - 16 * tt - 4 * fq - j; const bool ok = (diff >= 0) && (diff < 128) && (blk > 0 || (w + tt) >= 8);
                s[tt][j] = ok ? s[tt][j] : -INFINITY; mx = fmaxf(mx, s[tt][j]); }
        mx = fmaxf(mx, __shfl_xor(mx, 16)); mx = fmaxf(mx, __shfl_xor(mx, 32));
        float l = 0.f;
#pragma unroll
        for (int tt = 0; tt < 9; ++tt)
#pragma unroll
            for (int j = 0; j < 4; ++j) { s[tt][j] = __builtin_amdgcn_exp2f(s[tt][j] - mx); l += s[tt][j]; }
        l += __shfl_xor(l, 16); l += __shfl_xor(l, 32); l += __builtin_amdgcn_exp2f(sink2 - mx);
        const float inv = 1.f / l;
        f32x4 o[4];
#pragma unroll
        for (int dt = 0; dt < 4; ++dt) o[dt] = (f32x4){0.f, 0.f, 0.f, 0.f};
#pragma unroll
        for (int cc = 0; cc < 5; ++cc) { const int T1 = w + 2 * cc; const int T2c = (T1 + 1 > 15) ? 15 : (T1 + 1);
            u32x4 pw; pw.x = pk2(s[2 * cc][0], s[2 * cc][1]); pw.y = pk2(s[2 * cc][2], s[2 * cc][3]);
            if (cc < 4) { pw.z = pk2(s[2 * cc + 1 > 8 ? 8 : 2 * cc + 1][0], s[2 * cc + 1 > 8 ? 8 : 2 * cc + 1][1]); pw.w = pk2(s[2 * cc + 1 > 8 ? 8 : 2 * cc + 1][2], s[2 * cc + 1 > 8 ? 8 : 2 * cc + 1][3]); } else { pw.z = 0u; pw.w = 0u; }
            const bf16x8 pf = __builtin_bit_cast(bf16x8, pw);
#pragma unroll
            for (int dt = 0; dt < 4; ++dt) { const LAS unsigned char* vp = Vt + (16 * dt + fr) * VT_STRIDE;
                const u32x2 lo = *(const LAS u32x2*)(vp + (16 * T1 + 4 * fq) * 2), hi = *(const LAS u32x2*)(vp + (16 * T2c + 4 * fq) * 2);
                u32x4 av; av.x = lo.x; av.y = lo.y; av.z = hi.x; av.w = hi.y;
                o[dt] = __builtin_amdgcn_mfma_f32_16x16x32_bf16(__builtin_bit_cast(bf16x8, av), pf, o[dt], 0, 0, 0); } }
#pragma unroll
        for (int dt = 0; dt < 4; ++dt) { const int col = h * 64 + 16 * dt + 4 * fq;
            const u32x2 gt = graw[r][dt];
            u32x2 ov; ov.x = pk2(o[dt][0] * inv * bflo(gt.x), o[dt][1] * inv * bfhi(gt.x)); ov.y = pk2(o[dt][2] * inv * bflo(gt.y), o[dt][3] * inv * bfhi(gt.y));
            *(u32x2*)(AttnG + (size_t)tok * 1024 + col) = ov; }
    }
    __syncthreads();
}

constexpr int SW_RS = 68, SW_TILE = 16 * SW_RS * 4, SW_BYTES = 2 * SW_TILE;
constexpr int SSM_CH = 256, SSM_NCH = SEQ / SSM_CH, SSM_NST = SSM_CH / 16, SSM_ITEMS = 2 * 64 * SSM_NCH;
template <bool PASSB>
__device__ __forceinline__ void ssm_item(LAS unsigned char* wl, const Args& a, const bf16_t* P, float* E, bf16_t* Yg, int b, int g, int c, int lane) {
    const int fr = lane & 15, fq = lane >> 4;
    const float* D_skip = a.in[14];
    const f32x2 ab = ((const f32x2*)(a.ws + WS_TAB))[g * 64 + lane]; const float abr = ab.x, abi = ab.y;
    bf16x8 bq[8];
#pragma unroll
    for (int nt = 0; nt < 8; ++nt) bq[nt] = __builtin_bit_cast(bf16x8, ((const u32x4*)(a.ws + WS_TBQ))[(g * 8 + nt) * 64 + lane]);
    bf16x8 cch[4]; float dsk[4];
    if (PASSB) {
#pragma unroll
        for (int ks = 0; ks < 4; ++ks) cch[ks] = __builtin_bit_cast(bf16x8, ((const u32x4*)(a.ws + WS_TCC))[((g * 4 + ks) * 2 + 0) * 64 + lane]);
        const f32x4 dv = *(const f32x4*)(D_skip + g * 16 + 4 * fq); dsk[0] = dv[0]; dsk[1] = dv[1]; dsk[2] = dv[2]; dsk[3] = dv[3];
    }
    const long tok0 = (long)b * SEQ + (long)c * SSM_CH;
    const bf16_t* ub = P + ((size_t)(b * 64 + g) * 4096 + (size_t)c * SSM_CH + fr) * 16;
    float sr = 0.f, si = 0.f;
    if (PASSB) {
        const float* Eb = E + ((size_t)(b * 64 + g) * SSM_NCH) * 128;
        float pr = abr, pi = abi;
#pragma unroll
        for (int i = 0; i < 8; ++i) { const float nr = pr * pr - pi * pi, ni = 2.f * pr * pi; pr = nr; pi = ni; }
        float er[SSM_NCH - 1], ei[SSM_NCH - 1];
#pragma unroll
        for (int cp = 0; cp < SSM_NCH - 1; ++cp) { er[cp] = 0.f; ei[cp] = 0.f; if (cp < c) { er[cp] = Eb[(size_t)cp * 128 + lane]; ei[cp] = Eb[(size_t)cp * 128 + 64 + lane]; } }
#pragma unroll
        for (int cp = 0; cp < SSM_NCH - 1; ++cp) if (cp < c) { const float nr = fmaf(pr, sr, fmaf(-pi, si, er[cp])), ni = fmaf(pr, si, fmaf(pi, sr, ei[cp])); sr = nr; si = ni; }
    }
    LAS float* W0 = (LAS float*)wl; LAS float* W1 = (LAS float*)(wl + SW_TILE);
    u32x4 uc0 = *(const u32x4*)(ub + 8 * (fq & 1)), uc1 = *(const u32x4*)(ub + 256 + 8 * (fq & 1));
    u32x2 vc0 = (u32x2){0u, 0u}, vc1 = (u32x2){0u, 0u};
    if (PASSB) { vc0 = *(const u32x2*)(ub + 4 * fq); vc1 = *(const u32x2*)(ub + 256 + 4 * fq); }
#pragma unroll 1
    for (int sp = 0; sp < SSM_NST / 2; ++sp) {
        const int spn = (sp + 1 < SSM_NST / 2) ? sp + 1 : sp;
        const u32x4 un0 = *(const u32x4*)(ub + (size_t)spn * 512 + 8 * (fq & 1)), un1 = *(const u32x4*)(ub + (size_t)spn * 512 + 256 + 8 * (fq & 1));
        u32x2 vn0 = (u32x2){0u, 0u}, vn1 = (u32x2){0u, 0u};
        if (PASSB) { vn0 = *(const u32x2*)(ub + (size_t)spn * 512 + 4 * fq); vn1 = *(const u32x2*)(ub + (size_t)spn * 512 + 256 + 4 * fq); }
        const bf16x8 uf0 = __builtin_bit_cast(bf16x8, uc0), uf1 = __builtin_bit_cast(bf16x8, uc1);
#pragma unroll
        for (int nt = 0; nt < 8; ++nt) { const f32x4 z = (f32x4){0.f, 0.f, 0.f, 0.f};
            const f32x4 r0 = __builtin_amdgcn_mfma_f32_16x16x32_bf16(bq[nt], uf0, z, 0, 0, 0);
            const f32x4 r1 = __builtin_amdgcn_mfma_f32_16x16x32_bf16(bq[nt], uf1, z, 0, 0, 0);
            u32x2 k0, k1; k0.x = pk2c(r0[0], r0[1]); k0.y = pk2c(r0[2], r0[3]); k1.x = pk2c(r1[0], r1[1]); k1.y = pk2c(r1[2], r1[3]);
            *(LAS u32x2*)((LAS unsigned*)W0 + fr * SW_RS + 8 * nt + 2 * fq) = k0; *(LAS u32x2*)((LAS unsigned*)W1 + fr * SW_RS + 8 * nt + 2 * fq) = k1; }
        asm volatile("s_waitcnt lgkmcnt(0)" ::: "memory");
        f32x2 b0[16], b1[16];
#pragma unroll
        for (int t = 0; t < 16; ++t) { const unsigned q0 = ((const LAS unsigned*)W0)[t * SW_RS + lane], q1 = ((const LAS unsigned*)W1)[t * SW_RS + lane];
            b0[t] = (f32x2){bflo(q0), bfhi(q0)}; b1[t] = (f32x2){bflo(q1), bfhi(q1)}; }
        asm volatile("s_waitcnt lgkmcnt(0)" ::: "memory");
#pragma unroll
        for (int t = 0; t < 16; ++t) {
            const float nr = fmaf(abr, sr, fmaf(-abi, si, b0[t].x)), ni = fmaf(abr, si, fmaf(abi, sr, b0[t].y)); sr = nr; si = ni;
            if (PASSB) ((LAS unsigned*)W0)[t * SW_RS + lane] = pk2(sr, si); }
#pragma unroll
        for (int t = 0; t < 16; ++t) {
            const float nr = fmaf(abr, sr, fmaf(-abi, si, b1[t].x)), ni = fmaf(abr, si, fmaf(abi, sr, b1[t].y)); sr = nr; si = ni;
            if (PASSB) ((LAS unsigned*)W1)[t * SW_RS + lane] = pk2(sr, si); }
        if (PASSB) {
            asm volatile("s_waitcnt lgkmcnt(0)" ::: "memory");
            f32x4 y0 = (f32x4){0.f, 0.f, 0.f, 0.f}, y1 = (f32x4){0.f, 0.f, 0.f, 0.f};
#pragma unroll
            for (int ks = 0; ks < 4; ++ks) { const bf16x8 f0 = *(const LAS bf16x8*)((LAS unsigned*)W0 + fr * SW_RS + 16 * ks + 4 * fq), f1 = *(const LAS bf16x8*)((LAS unsigned*)W1 + fr * SW_RS + 16 * ks + 4 * fq);
                y0 = __builtin_amdgcn_mfma_f32_16x16x32_bf16(cch[ks], f0, y0, 0, 0, 0);
                y1 = __builtin_amdgcn_mfma_f32_16x16x32_bf16(cch[ks], f1, y1, 0, 0, 0); }
            { const float q0 = fgelu_tanh(y0[0] + dsk[0] * bflo(vc0.x)), q1 = fgelu_tanh(y0[1] + dsk[1] * bfhi(vc0.x)), q2 = fgelu_tanh(y0[2] + dsk[2] * bflo(vc0.y)), q3 = fgelu_tanh(y0[3] + dsk[3] * bfhi(vc0.y));
              u32x2 ov; ov.x = pk2(q0, q1); ov.y = pk2(q2, q3); *(u32x2*)(Yg + (size_t)(tok0 + 32 * sp + fr) * 1024 + 16 * g + 4 * fq) = ov; }
            { const float q0 = fgelu_tanh(y1[0] + dsk[0] * bflo(vc1.x)), q1 = fgelu_tanh(y1[1] + dsk[1] * bfhi(vc1.x)), q2 = fgelu_tanh(y1[2] + dsk[2] * bflo(vc1.y)), q3 = fgelu_tanh(y1[3] + dsk[3] * bfhi(vc1.y));
              u32x2 ov; ov.x = pk2(q0, q1); ov.y = pk2(q2, q3); *(u32x2*)(Yg + (size_t)(tok0 + 32 * sp + 16 + fr) * 1024 + 16 * g + 4 * fq) = ov; }
            asm volatile("s_waitcnt lgkmcnt(0)" ::: "memory");
        }
        asm volatile("" ::: "memory");
        uc0 = un0; uc1 = un1; vc0 = vn0; vc1 = vn1;
    }
    if (!PASSB) { float* Eo = E + ((size_t)((b * 64 + g) * SSM_NCH + c)) * 128; Eo[lane] = sr; Eo[64 + lane] = si; }
}

#define XB_TMO      128
#define XB_XCNT(j)  (256  + 64 * (j))
#define XB_XSUB(j)  (1280 + 64 * (j))
#define XB_XGEN(j)  (2304 + 64 * (j))
#define XB_TOP      3328
#define XB_TOPGEN   3392
#define XCD_BAR_WORDS 3456
#define XB_SPIN_CAP (1u << 18)

__device__ __forceinline__ unsigned xb_ld(unsigned* p)              { return __hip_atomic_load(p, __ATOMIC_RELAXED, __HIP_MEMORY_SCOPE_AGENT); }
__device__ __forceinline__ unsigned xb_add(unsigned* p, unsigned v) { return __hip_atomic_fetch_add(p, v, __ATOMIC_RELAXED, __HIP_MEMORY_SCOPE_AGENT); }
__device__ __forceinline__ unsigned xb_xcc_id() { return (unsigned)__builtin_amdgcn_s_getreg((3 << 11) | 20) & 0xFu; }
#define XB_SPIN(cond, bar) do { unsigned _sp = 0; while (cond) { __builtin_amdgcn_s_sleep(1); \
    if ((++_sp & 255u) == 0u) { if (xb_ld(&(bar)[XB_TMO])) break; if (_sp > XB_SPIN_CAP) { atomicAdd(&(bar)[XB_TMO], 1u); break; } } } } while (0)

struct XcdBarrier {
    unsigned* bar; unsigned x;
    volatile LAS unsigned* st;
};

__device__ __forceinline__ XcdBarrier xcd_barrier_post(unsigned* bar, volatile LAS unsigned* st) {
    XcdBarrier b; b.bar = bar; b.x = xb_xcc_id(); b.st = st;
    if (threadIdx.x == 0) (void)xb_add(&bar[XB_XCNT(b.x)], 1u);
    return b;
}
__device__ __forceinline__ void xcd_barrier_complete(unsigned* bar, unsigned x, unsigned& nloc, unsigned& nx) {
    const unsigned G = gridDim.x * gridDim.y * gridDim.z;
    unsigned sum, cnt, mine, sp = 0u;
    for (;;) {
        sum = 0u; cnt = 0u; mine = 0u;
#pragma unroll
        for (unsigned j = 0; j < 16; ++j) { const unsigned c = xb_ld(&bar[XB_XCNT(j)]); sum += c; cnt += (c > 0u) ? 1u : 0u; mine = (j == x) ? c : mine; }
        if (sum == G) break;
        __builtin_amdgcn_s_sleep(1);
        if ((++sp & 255u) == 0u) { if (xb_ld(&bar[XB_TMO])) break; if (sp > XB_SPIN_CAP) { atomicAdd(&bar[XB_TMO], 1u); break; } }
    }
    nloc = mine > 0u ? mine : 1u; nx = cnt > 0u ? cnt : 1u;
}

__device__ __forceinline__ void xcd_barrier(const XcdBarrier& b) {
    asm volatile("s_waitcnt vmcnt(0)" ::: "memory");
    __syncthreads();
    if (threadIdx.x == 0) {
        unsigned* bar = b.bar;
        __builtin_amdgcn_s_waitcnt(0);
        unsigned nloc = b.st[0], nx = b.st[1];
        if (nloc == 0u) { xcd_barrier_complete(bar, b.x, nloc, nx); b.st[0] = nloc; b.st[1] = nx; }
        const unsigned old = xb_add(&bar[XB_XSUB(b.x)], 1u);
        const unsigned gen = old / nloc;
        if (old + 1u == (gen + 1u) * nloc) {
            __builtin_amdgcn_fence(__ATOMIC_RELEASE, "agent");
            asm volatile("s_waitcnt vmcnt(0)" ::: "memory");
            const unsigned og = xb_add(&bar[XB_TOP], 1u);
            const unsigned tg = og / nx;
            if (og + 1u == (tg + 1u) * nx) xb_add(&bar[XB_TOPGEN], 1u);
            else XB_SPIN(xb_ld(&bar[XB_TOPGEN]) == tg, bar);
            __builtin_amdgcn_fence(__ATOMIC_ACQUIRE, "agent");
            xb_add(&bar[XB_XGEN(b.x)], 1u);
            asm volatile("s_waitcnt vmcnt(0)" ::: "memory");
        } else {
            XB_SPIN(xb_ld(&bar[XB_XGEN(b.x)]) == gen, bar);
            __builtin_amdgcn_fence(__ATOMIC_ACQUIRE, "agent");
            asm volatile("s_waitcnt vmcnt(0)" ::: "memory");
        }
    }
    __syncthreads();
}


#define EB_CNT  3520
#define EB_WORK 3584
#define EB_CNT2 3648
__device__ __forceinline__ void eb_arrive(unsigned* bar) {
    __builtin_amdgcn_fence(__ATOMIC_RELEASE, "agent");
    asm volatile("s_waitcnt vmcnt(0)" ::: "memory");
    (void)xb_add(&bar[EB_CNT], 1u);
}
__device__ __forceinline__ void eb_wait(unsigned* bar, unsigned want) {
    if (threadIdx.x == 0) {
        XB_SPIN(xb_ld(&bar[EB_CNT]) < want, bar);
        __builtin_amdgcn_fence(__ATOMIC_ACQUIRE, "agent");
        asm volatile("s_waitcnt vmcnt(0)" ::: "memory");
    }
    __syncthreads();
}
namespace pg8 {
struct OrderDual : StaticOrder {
    unsigned* bar; unsigned want;
    __device__ __forceinline__ bool next(int i, Unit& u) const { const bool ok = StaticOrder::next(i >> 1, u); u.w = i & 1; return ok; }
    __device__ __forceinline__ void a_ready(const Unit& u) const {
        if (u.w == 1) {
            if (threadIdx.x < 64) {
                unsigned sp = 0;
                while ((unsigned)__builtin_amdgcn_readfirstlane(xb_ld(&bar[EB_CNT2])) < want) { __builtin_amdgcn_s_sleep(2); if (++sp > (1u << 22)) break; }
                __builtin_amdgcn_fence(__ATOMIC_ACQUIRE, "agent");
                asm volatile("s_waitcnt vmcnt(0)" ::: "memory");
            }
            asm volatile("" ::: "memory"); __builtin_amdgcn_s_barrier(); asm volatile("" ::: "memory");
        }
    }
};
struct OrderP1 : StaticOrder {
    int pm3, pn3; unsigned* bar;
    __device__ __forceinline__ void done(const Unit& u) const {
        if (u.pm == pm3 && u.pn == pn3) {
            asm volatile("s_waitcnt vmcnt(0)" ::: "memory"); __builtin_amdgcn_s_barrier();
            if (threadIdx.x == 0) eb_arrive(bar);
        }
    }
};
}

__global__ void __launch_bounds__(512, 2) fwd(Args a) {
    extern __shared__ __attribute__((aligned(16))) unsigned char lds_raw[];
    LAS unsigned char* lds = (LAS unsigned char*)lds_raw;
    cg::grid_group grid = cg::this_grid();
    const int tid = threadIdx.x, lane = tid & 63, wave = __builtin_amdgcn_readfirstlane(tid >> 6);
    const int G = gridDim.x, bx = blockIdx.x;
    unsigned char* ws = a.ws;
    bf16_t* WinT = (bf16_t*)(ws + WS_WIN); bf16_t* WattnT = (bf16_t*)(ws + WS_WATTN); bf16_t* WgluT = (bf16_t*)(ws + WS_WGLU); bf16_t* WssmT = (bf16_t*)(ws + WS_WSSM); bf16_t* WoutT = (bf16_t*)(ws + WS_WOUT);
    bf16_t* H = (bf16_t*)(ws + WS_H); bf16_t* AttnG = (bf16_t*)(ws + WS_ATTNG); bf16_t* Yg = (bf16_t*)(ws + WS_YG); bf16_t* P = (bf16_t*)(ws + WS_P); bf16_t* Mg = (bf16_t*)(ws + WS_MG);
    bf16_t* T = (bf16_t*)((unsigned char*)a.out + OUT_T); float* E = (float*)((unsigned char*)a.out + OUT_E); bf16_t* U2 = (bf16_t*)((unsigned char*)a.out + OUT_U2);
    const int lo = a.ph_lo, hi = a.ph_hi;
#define IN(k) (lo <= (k) && (k) < hi)
    if (tid < 16) ((LAS unsigned*)(lds + LDS_CTL))[tid] = 0u;
    __syncthreads();
    XcdBarrier bar = xcd_barrier_post((unsigned*)(ws + WS_BAR), (volatile LAS unsigned*)(lds + LDS_CTL) + 8);
    if (hi == 99) grid.sync();
#define SEAM(k) do { if (IN(k) && IN((k) + 1)) xcd_barrier(bar); } while (0)

    if (IN(0)) { p0_prologue(a, lds, wave, lane); __syncthreads(); }
    SEAM(0);
    const bool fuse12 = (lo == 0 && hi == 7 && G == 256);
    if (fuse12) {
        unsigned* bw = (unsigned*)(ws + WS_BAR);
        { pg8::Gemm g{H, WinT, MTOK, INW, DM}; pg8::OrderP1 S; S.init(MTOK, INW, G, bx); S.bar = bw; { pg8::Unit u3; S.next(3, u3); S.pm3 = u3.pm; S.pn3 = u3.pn; }
          pg8::EpiProj Ep{P, U2};
          pg8::gemm_phase<pg8::EpiProj, pg8::OrderP1, true, true>(lds, g, S, Ep); }
        __syncthreads();
        if (bx >= 64) p0_weights(a, (LAS float*)(lds + wave * 16384), P0_I_IN, P0_NITEMS, (bx - 64) * 8 + wave, (G - 64) * 8, lane);
        eb_wait(bw, (unsigned)G);
        LAS unsigned* tk = (LAS unsigned*)(lds + LDS_CTL) + 4;
        for (;;) {
            if (tid == 0) *tk = xb_add(&bw[EB_WORK], 1u);
            __syncthreads();
            const unsigned t = *tk;
            __syncthreads();
            if (t >= 512u) break;
            if (t < 256u) { const int u = (int)t; const int g = u & 3, blk = (u >> 2) & 31, b = u >> 7; attn_unit(lds, P, AttnG, a.in[3], a.in[4], a.in[5], b, blk, g, tid); }
            else { const int it = (int)(t - 256u) * 8 + wave; const int c = it & (SSM_NCH - 1), g = (it / SSM_NCH) & 63, b = it / (SSM_NCH * 64); ssm_item<false>(lds + wave * SW_BYTES, a, U2, E, Yg, b, g, c, lane); __syncthreads(); }
        }
    } else {
    if (IN(1)) { pg8::Gemm g{H, WinT, MTOK, INW, DM}; pg8::StaticOrder S; S.init(MTOK, INW, G, bx); pg8::EpiProj Ep{P, U2};
        pg8::gemm_phase<pg8::EpiProj, pg8::StaticOrder, true, true>(lds, g, S, Ep);
        { const int n5 = (MTOK / 256) * (INW / 256) - 4 * G;
          if (n5 > 0 && n5 < G && G * 4 < (MTOK / 256) * (INW / 256)) { if (bx >= n5) { __syncthreads(); p0_weights(a, (LAS float*)(lds + wave * 16384), P0_I_IN, P0_NITEMS, (bx - n5) * 8 + wave, (G - n5) * 8, lane); } }
          else { __syncthreads(); p0_weights(a, (LAS float*)(lds + wave * 16384), P0_I_IN, P0_NITEMS, bx * 8 + wave, G * 8, lane); } }
    }
    SEAM(1);
    if (IN(2)) {
        for (int u = bx; u < 256; u += G) { const int g = u & 3, blk = (u >> 2) & 31, b = u >> 7; attn_unit(lds, P, AttnG, a.in[3], a.in[4], a.in[5], b, blk, g, tid); }
        const int gw = bx * 8 + wave, NGW = G * 8;
        for (int it = gw; it < SSM_ITEMS; it += NGW) { const int c = it & (SSM_NCH - 1), g = (it / SSM_NCH) & 63, b = it / (SSM_NCH * 64); ssm_item<false>(lds + wave * SW_BYTES, a, U2, E, Yg, b, g, c, lane); }
        __syncthreads();
    }
    }
    SEAM(2);
    if (IN(3)) {
        const int gw = bx * 8 + wave, NGW = G * 8;
        if (G == 256 && SSM_NCH == 16) {
            const int b = bx >> 7, gq = (bx >> 3) & 15, cp = bx & 7; const int g = 4 * gq + (wave & 3), c = 2 * cp + (wave >> 2);
            ssm_item<true>(lds + wave * SW_BYTES, a, U2, E, Yg, b, g, c, lane);
        } else
        for (int it = gw; it < SSM_ITEMS; it += NGW) { const int c = it & (SSM_NCH - 1), g = (it / SSM_NCH) & 63, b = it / (SSM_NCH * 64); ssm_item<true>(lds + wave * SW_BYTES, a, U2, E, Yg, b, g, c, lane); }
        __syncthreads();
    }
    SEAM(3);
    const bool split45 = (lo == 0 && hi == 7 && G == 256);
    if (IN(4)) { pg8::Gemm g{Yg, WgluT, MTOK, DM, 1024}; pg8::StaticOrder S; S.init(MTOK, DM, G, bx); pg8::EpiGlu Ep{P, T, a.in[16]};
        pg8::gemm_phase<pg8::EpiGlu, pg8::StaticOrder, true, true>(lds, g, S, Ep);
        if (split45 && tid == 0) { __builtin_amdgcn_fence(__ATOMIC_RELEASE, "agent"); asm volatile("s_waitcnt vmcnt(0)" ::: "memory"); (void)xb_add(&((unsigned*)(ws + WS_BAR))[EB_CNT2], 1u); } }
    if (!split45) SEAM(4);
    if (IN(5)) { pg8::Gemm g{AttnG, WattnT, MTOK, DM, 1024, T, WssmT}; pg8::OrderDual S; S.init(MTOK, DM, G, bx); S.bar = (unsigned*)(ws + WS_BAR); S.want = split45 ? (unsigned)G : 0u; pg8::EpiDual Ep{P, Mg};
        pg8::gemm_phase<pg8::EpiDual, pg8::OrderDual, true, true>(lds, g, S, Ep); }
    SEAM(5);
    if (IN(6)) { pg8::Gemm g{Mg, WoutT, MTOK, DM, DM}; pg8::StaticOrder S; S.init(MTOK, DM, G, bx); pg8::EpiOut Ep{a.in[0], a.out};
        pg8::gemm_phase<pg8::EpiOut, pg8::StaticOrder, true, true>(lds, g, S, Ep); }
#undef IN
#undef SEAM
}

extern "C" void kernel_launch(void* const* d_in, const int* in_sizes, int n_in, void* d_out, int out_size, void* d_ws, size_t ws_size, hipStream_t stream) {
    static int grid = 0;
    if (grid == 0) {
        if (n_in != 19 || out_size != MTOK * DM || ws_size < WS_END) { fprintf(stderr, "kernel_launch: unexpected shapes (n_in %d out %d ws %zu)\n", n_in, out_size, ws_size); grid = -1; return; }
        int dev = 0, cus = 0, per_cu = 0;
        (void)hipGetDevice(&dev); (void)hipDeviceGetAttribute(&cus, hipDeviceAttributeMultiprocessorCount, dev);
        (void)hipFuncSetAttribute((const void*)fwd, hipFuncAttributeMaxDynamicSharedMemorySize, LDS_BYTES);
        (void)hipOccupancyMaxActiveBlocksPerMultiprocessor(&per_cu, (const void*)fwd, 512, LDS_BYTES);
        if (per_cu < 1) per_cu = 1;
        grid = cus * per_cu;
        (void)hipGetLastError();
    }
    if (grid < 0) return;
    if (MK_N_LAUNCHES == 1) (void)hipMemsetAsync((unsigned char*)d_ws + WS_BAR, 0, WS_BAR_BYTES, stream);
    Args a{};
    for (int i = 0; i < 19; ++i) a.in[i] = (const float*)d_in[i];
    a.out = (float*)d_out; a.ws = (unsigned char*)d_ws;
#if MK_N_LAUNCHES == 1
    a.ph_lo = 0; a.ph_hi = 7;
    void* args[] = {&a};
    hipError_t e = hipLaunchCooperativeKernel((const void*)fwd, dim3(grid), dim3(512), args, LDS_BYTES, stream);
    if (e != hipSuccess) fprintf(stderr, "cooperative launch failed: %s (grid %d)\n", hipGetErrorString(e), grid);
#else
    for (int ph = 0; ph < 7; ++ph) { a.ph_lo = ph; a.ph_hi = ph + 1; hipLaunchKernelGGL(fwd, dim3(grid), dim3(512), LDS_BYTES, stream, a); }
#endif
}
```
